# Optimizing an MI355X kernel written in HIP

```python
import math
import jax, jax.numpy as jnp
from jax import lax
import numpy as np

D_MODEL = 1024
BATCH = 16
SEQ = 2048
DEPTH = 1
DEC_BATCH = 1
DEC_SEQ = 16384
PAST_LEN = 128

PLE_DIM = 256
DA_HEADS = 4
DA_QK_DIM = 64
DA_V_DIM = 2 * DA_QK_DIM
DA_WIDTH = DA_HEADS * DA_V_DIM
GLA_HEADS = 4
GLA_DK = 64
GLA_DV = 128
GLA_WIDTH = GLA_HEADS * GLA_DV
GLA_GATE_RANK = 16
GLA_GATE_NORM = 16.0
GLA_CHUNK = 64
MIX_WIDTH = DA_WIDTH + GLA_WIDTH
D_FF = 4 * D_MODEL
CONV_WIDTH = 3
Q_BLOCK = 128
NORM_EPS = 1e-6

IN_SPLITS = (DA_HEADS * 2 * DA_QK_DIM,
             DA_HEADS * 2 * DA_QK_DIM,
             DA_WIDTH,
             GLA_HEADS * GLA_DK,
             GLA_HEADS * GLA_DK,
             GLA_WIDTH,
             GLA_WIDTH,
             GLA_GATE_RANK,
             GLA_GATE_RANK)
IN_WIDTH = sum(IN_SPLITS)

kernel_name = 'hymba_diffattn_gla_convffn_encoder'


def _split_points():
    pts, acc = [], 0
    for w in IN_SPLITS[:-1]:
        acc += w
        pts.append(acc)
    return pts


def rmsnorm(x, g):
    xf = x.astype(jnp.float32)
    y = xf * lax.rsqrt(jnp.mean(xf * xf, axis=-1, keepdims=True) + NORM_EPS)
    return (y * g.astype(jnp.float32)).astype(x.dtype)


def alibi_slopes(n):
    return jnp.asarray([2.0 ** (-8.0 * (h + 1) / n) for h in range(n)], jnp.float32)


def diff_attention(q, k, v, lam):
    B, S = q.shape[0], q.shape[1]
    nblk = S // Q_BLOCK
    scale = DA_QK_DIM ** -0.5
    slopes = alibi_slopes(DA_HEADS)
    kpos = jnp.arange(S, dtype=jnp.float32)
    qb = q.reshape(B, nblk, Q_BLOCK, DA_HEADS, 2, DA_QK_DIM).transpose(1, 0, 2, 3, 4, 5)

    def block(args):
        qi, blk = args
        qpos = (blk * Q_BLOCK + jnp.arange(Q_BLOCK)).astype(jnp.float32)
        dist = jnp.abs(qpos[:, None] - kpos[None, :])
        bias = -slopes[:, None, None] * dist[None]
        s = jnp.einsum('bqhmd,bkhmd->bhmqk', qi, k).astype(jnp.float32) * scale
        a = jax.nn.softmax(s + bias[None, :, None], axis=-1)
        w = a[:, :, 0] - lam * a[:, :, 1]
        return jnp.einsum('bhqk,bkhe->bqhe', w.astype(v.dtype), v)

    out = lax.map(block, (qb, jnp.arange(nblk)))
    return out.transpose(1, 0, 2, 3, 4).reshape(B, S, DA_HEADS, DA_V_DIM)


def gla_direction(q, k, v, g, include_diag):
    B, S, H, dk = q.shape
    dv = v.shape[-1]
    C = GLA_CHUNK
    N = S // C
    f32 = jnp.float32
    qc = q.astype(f32).reshape(B, N, C, H, dk)
    kc = k.astype(f32).reshape(B, N, C, H, dk)
    vc = v.astype(f32).reshape(B, N, C, H, dv)
    gc = g.astype(f32).reshape(B, N, C, H, dk)
    b = jnp.cumsum(gc, axis=2)
    b_last = b[:, :, -1]
    q_t = qc * jnp.exp(b)
    k_t = kc * jnp.exp(-b)
    k_end = kc * jnp.exp(b_last[:, :, None] - b)
    mask = jnp.tril(jnp.ones((C, C), dtype=bool), 0 if include_diag else -1)
    att = jnp.where(mask, jnp.einsum('bnchd,bnshd->bnhcs', q_t, k_t), 0.0)
    o_intra = jnp.einsum('bnhcs,bnshe->bnche', att, vc)
    kv = jnp.einsum('bnshd,bnshe->nbhde', k_end, vc)
    decay = jnp.exp(b_last).transpose(1, 0, 2, 3)

    def step(state, inp):
        kv_n, dec_n = inp
        return dec_n[..., None] * state + kv_n, state

    s0 = jnp.zeros((B, H, dk, dv), f32)
    _, s_prev = lax.scan(step, s0, (kv, decay))
    o_inter = jnp.einsum('bnchd,nbhde->bnche', q_t, s_prev)
    return (o_intra + o_inter).reshape(B, S, H, dv)


def dwconv3(u, w, b):
    up = jnp.pad(u, ((0, 0), (1, 1), (0, 0)))
    return up[:, :-2] * w[0] + up[:, 1:-1] * w[1] + up[:, 2:] * w[2] + b


def encoder_layer(x, p, lam_init, pre_mix_g, w_in, da_lq1, da_lk1, da_lq2, da_lk2,
                  da_norm_g, gla_w_gate_f, gla_b_gate_f, gla_w_gate_b, gla_b_gate_b,
                  gla_norm_g, w_out, post_mix_g, pre_ffn_g, w_ffn_up, ffn_conv_w,
                  ffn_conv_b, w_ffn_down, post_ffn_g, w_ple_gate, b_ple_gate,
                  w_ple_proj, ple_norm_g):
    B, S, _ = x.shape
    h = rmsnorm(x, pre_mix_g)
    proj = h @ w_in
    (da_q, da_k, da_v, gq, gk, gv, gr, lr_f, lr_b) = jnp.split(proj, _split_points(), axis=-1)

    lam = (jnp.exp(jnp.sum(da_lq1.astype(jnp.float32) * da_lk1.astype(jnp.float32)))
           - jnp.exp(jnp.sum(da_lq2.astype(jnp.float32) * da_lk2.astype(jnp.float32)))
           + lam_init)
    da = diff_attention(da_q.reshape(B, S, DA_HEADS, 2, DA_QK_DIM),
                        da_k.reshape(B, S, DA_HEADS, 2, DA_QK_DIM),
                        da_v.reshape(B, S, DA_HEADS, DA_V_DIM), lam)
    da = rmsnorm(da, da_norm_g) * (1.0 - lam_init)

    q = (gq * GLA_DK ** -0.5).reshape(B, S, GLA_HEADS, GLA_DK)
    k = gk.reshape(B, S, GLA_HEADS, GLA_DK)
    v = gv.reshape(B, S, GLA_HEADS, GLA_DV)
    g_f = (jax.nn.log_sigmoid((lr_f @ gla_w_gate_f + gla_b_gate_f).astype(jnp.float32))
           / GLA_GATE_NORM).reshape(B, S, GLA_HEADS, GLA_DK)
    g_b = (jax.nn.log_sigmoid((lr_b @ gla_w_gate_b + gla_b_gate_b).astype(jnp.float32))
           / GLA_GATE_NORM).reshape(B, S, GLA_HEADS, GLA_DK)
    o_f = gla_direction(q, k, v, g_f, True)
    o_b = jnp.flip(gla_direction(jnp.flip(q, 1), jnp.flip(k, 1), jnp.flip(v, 1),
                                 jnp.flip(g_b, 1), False), 1)
    gla = rmsnorm((o_f + o_b).astype(x.dtype), gla_norm_g)
    gla = gla * jax.nn.silu(gr.reshape(B, S, GLA_HEADS, GLA_DV))

    mix = jnp.concatenate([da.reshape(B, S, DA_WIDTH).astype(x.dtype),
                           gla.reshape(B, S, GLA_WIDTH).astype(x.dtype)], axis=-1) @ w_out
    x = x + rmsnorm(mix, post_mix_g)

    h = rmsnorm(x, pre_ffn_g)
    gate, up = jnp.split(h @ w_ffn_up, 2, axis=-1)
    act = jax.nn.gelu(dwconv3(gate, ffn_conv_w, ffn_conv_b)) * up
    x = x + rmsnorm(act @ w_ffn_down, post_ffn_g)

    e = rmsnorm(p.astype(x.dtype) @ w_ple_proj, ple_norm_g)
    x = x + jax.nn.sigmoid(x @ w_ple_gate + b_ple_gate) * e
    return x


def setup_inputs(seed: int = 0) -> dict:
    key = jax.random.key(seed)
    ks = iter(jax.random.split(key, 40))
    f32 = jnp.float32

    def nrm(shape, scale):
        return jax.random.normal(next(ks), shape, f32) * scale

    def gain(n):
        return 1.0 + nrm((DEPTH, n), 0.02)

    L = DEPTH
    return {
        'x_prompt': nrm((BATCH, SEQ, D_MODEL), 1.0),
        'x_sample': nrm((DEC_BATCH, DEC_SEQ, D_MODEL), 1.0),
        'p_prompt': nrm((DEPTH, BATCH, SEQ, PLE_DIM), 1.0),
        'p_sample': nrm((DEPTH, DEC_BATCH, DEC_SEQ, PLE_DIM), 1.0),
        'pre_mix_g': gain(D_MODEL),
        'w_in': nrm((L, D_MODEL, IN_WIDTH), D_MODEL ** -0.5),
        'da_lq1': nrm((L, DA_QK_DIM), 0.1),
        'da_lk1': nrm((L, DA_QK_DIM), 0.1),
        'da_lq2': nrm((L, DA_QK_DIM), 0.1),
        'da_lk2': nrm((L, DA_QK_DIM), 0.1),
        'da_norm_g': gain(DA_V_DIM),
        'gla_w_gate_f': nrm((L, GLA_GATE_RANK, GLA_HEADS * GLA_DK), GLA_GATE_RANK ** -0.5),
        'gla_b_gate_f': nrm((L, GLA_HEADS * GLA_DK), 0.1),
        'gla_w_gate_b': nrm((L, GLA_GATE_RANK, GLA_HEADS * GLA_DK), GLA_GATE_RANK ** -0.5),
        'gla_b_gate_b': nrm((L, GLA_HEADS * GLA_DK), 0.1),
        'gla_norm_g': gain(GLA_DV),
        'w_out': nrm((L, MIX_WIDTH, D_MODEL), MIX_WIDTH ** -0.5),
        'post_mix_g': gain(D_MODEL),
        'pre_ffn_g': gain(D_MODEL),
        'w_ffn_up': nrm((L, D_MODEL, 2 * D_FF), D_MODEL ** -0.5),
        'ffn_conv_w': nrm((L, CONV_WIDTH, D_FF), CONV_WIDTH ** -0.5),
        'ffn_conv_b': nrm((L, D_FF), 0.01),
        'w_ffn_down': nrm((L, D_FF, D_MODEL), D_FF ** -0.5),
        'post_ffn_g': gain(D_MODEL),
        'w_ple_gate': nrm((L, D_MODEL, D_MODEL), D_MODEL ** -0.5),
        'b_ple_gate': nrm((L, D_MODEL), 0.01),
        'w_ple_proj': nrm((L, PLE_DIM, D_MODEL), PLE_DIM ** -0.5),
        'ple_norm_g': gain(D_MODEL),
    }


def reference(x_prompt, x_sample, p_prompt, p_sample, pre_mix_g, w_in, da_lq1, da_lk1,
              da_lq2, da_lk2, da_norm_g, gla_w_gate_f, gla_b_gate_f, gla_w_gate_b,
              gla_b_gate_b, gla_norm_g, w_out, post_mix_g, pre_ffn_g, w_ffn_up,
              ffn_conv_w, ffn_conv_b, w_ffn_down, post_ffn_g, w_ple_gate, b_ple_gate,
              w_ple_proj, ple_norm_g):
    def trunk(x, p):
        for l in range(DEPTH):
            lam_init = 0.8 - 0.6 * math.exp(-0.3 * l)
            x = encoder_layer(x, p[l], lam_init, pre_mix_g[l], w_in[l], da_lq1[l],
                              da_lk1[l], da_lq2[l], da_lk2[l], da_norm_g[l],
                              gla_w_gate_f[l], gla_b_gate_f[l], gla_w_gate_b[l],
                              gla_b_gate_b[l], gla_norm_g[l], w_out[l], post_mix_g[l],
                              pre_ffn_g[l], w_ffn_up[l], ffn_conv_w[l], ffn_conv_b[l],
                              w_ffn_down[l], post_ffn_g[l], w_ple_gate[l], b_ple_gate[l],
                              w_ple_proj[l], ple_norm_g[l])
        return x

    y_prompt = trunk(x_prompt, p_prompt)
    y_sample = trunk(x_sample, p_sample)
    return (y_prompt, y_sample)
```

```cpp
#include <hip/hip_runtime.h>
#include <hip/hip_cooperative_groups.h>
#include <cstdio>
#include <cstdint>
namespace cg = cooperative_groups;
namespace pg8 {
#define PG8_LAS __attribute__((address_space(3)))
typedef unsigned short bf16_t;
typedef short bf16x8 __attribute__((ext_vector_type(8)));
typedef float f32x4 __attribute__((ext_vector_type(4)));
typedef unsigned u32x4 __attribute__((ext_vector_type(4)));
constexpr int BM = 256, BK = 64, HALF = 128, HTB = HALF * BK * 2  , STAGE_BYTES = 8 * HTB, NXCD = 8, WGM = 8;

__host__ __device__ __forceinline__ int lds_byte(int r, int c) { const int st = (r >> 4) * 2 + (c >> 5), rr = r & 15, cc = c & 31, ob = rr * 64 + cc * 2; return st * 1024 + (ob ^ (((ob >> 9) & 1) << 5)); }
__host__ __device__ __forceinline__ void stage_rc(int b, int& R, int& C) { const int st = b / 1024, sb = b % 1024, swz = sb ^ (((sb >> 9) & 1) << 5); R = (st >> 1) * 16 + swz / 64; C = (st & 1) * 32 + (swz % 64) / 2; }
__host__ __device__ __forceinline__ int perm32(int rho) { const int n = rho >> 4, i = rho & 15; return 8 * (i >> 2) + 4 * n + (i & 3); }

struct Unit { int pm, pn; };
struct Gemm { const bf16_t* A; const bf16_t* Bt; int M, N, K; };

struct StaticOrder {
    int nM, nN, nwg, G, c;
    __host__ __device__ void init(int M, int N, int G_, int c_) { nM = M / BM; nN = N / BM; nwg = nM * nN; G = G_; c = c_; }
    __host__ __device__ bool next(int i, Unit& u) const {
        const long L = (long)i * G + c; if (L >= nwg) return false;
        int wgid = (int)L; { const int q = nwg / NXCD, r = nwg % NXCD, xcd = wgid % NXCD, off = wgid / NXCD; wgid = (xcd < r ? xcd * (q + 1) : r * (q + 1) + (xcd - r) * q) + off; }
        const int nig = WGM * nN, gid = wgid / nig, fm = gid * WGM, gsz = (nM - fm) < WGM ? (nM - fm) : WGM;
        u.pm = fm + ((wgid % nig) % gsz); u.pn = (wgid % nig) / gsz; return true;
    }
    __device__ __forceinline__ void a_ready(const Unit&) const {}
    __device__ __forceinline__ void done(const Unit&) const {}
};

__device__ __forceinline__ unsigned cvt_pk_bf16(float lo, float hi) { unsigned r; asm volatile("v_cvt_pk_bf16_f32 %0, %1, %2" : "=v"(r) : "v"(lo), "v"(hi)); return r; }
typedef float f32x2 __attribute__((ext_vector_type(2)));
typedef float f32x2 __attribute__((ext_vector_type(2)));
struct EpiBf16S {
    static constexpr bool PERM = true, AFTER_DRAIN = false;
    bf16_t* O; int ldc; int scale_tiles; float scale0;
    __device__ __forceinline__ void operator()(const f32x4 (&acc)[2][2][4][2], const Unit& u, int wr, int wc, int fr, int fq) const {
        const int row0 = u.pm * BM + wr * 64 + fr; const int col0 = u.pn * BM + wc * 32 + 8 * fq; const float sc = (u.pn < scale_tiles) ? scale0 : 1.f;
#pragma unroll
        for (int ai = 0; ai < 2; ++ai)
#pragma unroll
            for (int m = 0; m < 4; ++m) { bf16_t* rowp = O + (size_t)(row0 + ai * HALF + m * 16) * ldc + col0;
#pragma unroll
                for (int bj = 0; bj < 2; ++bj) { const f32x4 v0 = acc[ai][bj][m][0] * sc, v1 = acc[ai][bj][m][1] * sc;
                    u32x4 w; w.x = cvt_pk_bf16(v0[0], v0[1]); w.y = cvt_pk_bf16(v0[2], v0[3]); w.z = cvt_pk_bf16(v1[0], v1[1]); w.w = cvt_pk_bf16(v1[2], v1[3]);
                    __builtin_nontemporal_store(w, (u32x4*)(rowp + bj * HALF)); } }
    }
};
__device__ __forceinline__ float dpp_ror1(float v) { return __builtin_bit_cast(float, __builtin_amdgcn_update_dpp(0, __builtin_bit_cast(int, v), 0x121, 0xf, 0xf, false)); }
__device__ __forceinline__ float dpp_ror15(float v) { return __builtin_bit_cast(float, __builtin_amdgcn_update_dpp(0, __builtin_bit_cast(int, v), 0x12F, 0xf, 0xf, false)); }
__device__ __forceinline__ float gelu_tanh(float v) {
    const float inner = v * fmaf(0.044715f, v * v, 1.0f);
    const float e = __builtin_amdgcn_exp2f(inner * (-2.0f * 0.7978845608028654f * 1.4426950408889634f));
    return v * __builtin_amdgcn_rcpf(1.0f + e);
}
struct EpiConvGelu {
    static constexpr bool PERM = true, AFTER_DRAIN = false;
    bf16_t* ACT; const float* cw; const float* cb; int nmain; int mrows;
    __device__ __forceinline__ void operator()(const f32x4 (&acc)[2][2][4][2], const Unit& u, int wr, int wc, int fr, int fq) const {
        const bool fix = u.pm >= nmain;
        const int ch0 = u.pn * 128 + wc * 32 + 8 * fq;
        f32x4 w0[2], w1[2], w2[2], bb[2];
#pragma unroll
        for (int n = 0; n < 2; ++n) { w0[n] = *(const f32x4*)(cw + ch0 + 4 * n); w1[n] = *(const f32x4*)(cw + 4096 + ch0 + 4 * n); w2[n] = *(const f32x4*)(cw + 8192 + ch0 + 4 * n); bb[n] = *(const f32x4*)(cb + ch0 + 4 * n); }
#pragma unroll
        for (int ai = 0; ai < 2; ++ai)
#pragma unroll
            for (int m = 0; m < 4; ++m) {
                bool valid; int grow; bool zp = false, zn = false;
                if (!fix) { valid = !((ai == 0 && m == 0 && fr == 0) || (ai == 1 && m == 3 && fr == 15)); grow = u.pm * BM + wr * HALF + ai * 64 + m * 16 + fr; }
                else { const int R = (u.pm - nmain) * BM + wr * HALF + ai * 64 + m * 16 + fr; const int grp = R >> 2, pos = R & 3;
                    const bool ss = (grp < 256) ? ((grp & 15) == 0) : (grp == 256);
                    valid = (pos == 1) || (pos == 2); grow = (pos == 1) ? ((grp * 128 - 1 + mrows) % mrows) : (grp * 128);
                    zn = (pos == 1) && ss; zp = (pos == 2) && ss; }
                f32x4 res[2];
                const float fzp = zp ? 0.f : 1.f, fzn = zn ? 0.f : 1.f;
#pragma unroll
                for (int n = 0; n < 2; ++n) {
                    const f32x4 g = acc[ai][0][m][n], up = acc[ai][1][m][n];
                    f32x4 tp = g, tn = g;
                    if (!fix) { const f32x4 gm = (m > 0) ? acc[ai][0][m - 1][n] : acc[ai ^ 1][0][3][n], gx = (m < 3) ? acc[ai][0][m + 1][n] : acc[ai ^ 1][0][0][n];
                        tp = (fr == 15) ? gm : g; tn = (fr == 0) ? gx : g; }
                    f32x4 gp, gn;
#pragma unroll
                    for (int j = 0; j < 4; ++j) { gp[j] = dpp_ror1(tp[j]); gn[j] = dpp_ror15(tn[j]); }
                    const f32x4 cv = (w0[n] * fzp) * gp + (w1[n] * g + ((w2[n] * fzn) * gn + bb[n]));
                    const f32x4 inner = cv * (cv * cv * 0.044715f + 1.0f) * (-2.0f * 0.7978845608028654f * 1.4426950408889634f);
                    f32x4 sg;
#pragma unroll
                    for (int j = 0; j < 4; ++j) sg[j] = __builtin_amdgcn_rcpf(1.0f + __builtin_amdgcn_exp2f(inner[j]));
                    res[n] = cv * sg * up;
                }
                if (valid) { u32x4 w; w.x = cvt_pk_bf16(res[0][0], res[0][1]); w.y = cvt_pk_bf16(res[0][2], res[0][3]); w.z = cvt_pk_bf16(res[1][0], res[1][1]); w.w = cvt_pk_bf16(res[1][2], res[1][3]);
                    __builtin_nontemporal_store(w, (u32x4*)(ACT + (size_t)grow * 4096 + ch0)); }
            }
    }
};
template <class Epi, class Sched, bool ALIGN_EPI = false, bool SP2 = false, bool AROWS128 = false>
__device__ __forceinline__ void gemm_phase(PG8_LAS unsigned char* lds, const Gemm g, const Sched& S, const Epi& E) {
    int tid_ = threadIdx.x; asm volatile("" : "+v"(tid_)); const int tid = tid_, wid = __builtin_amdgcn_readfirstlane(tid >> 6), lane = tid & 63, wr = wid >> 2, wc = wid & 3, fr = lane & 15, fq = lane >> 4;
    const int K = g.K, nt = K / BK;
    unsigned voffA[2], voffB[2];
#pragma unroll
    for (int i = 0; i < 2; ++i) { int R, C; stage_rc(tid * 16 + i * 8192, R, C); const int Rb = Epi::PERM ? ((R & ~31) + perm32(R & 31)) : R;
        const int Ra = AROWS128 ? (128 * (R >> 6) + (R & 63)) : R;
        voffA[i] = (unsigned)(Ra * K + C) * 2u; voffB[i] = (unsigned)(Rb * K + C) * 2u; }
    const size_t kstep = (size_t)(BK * 2);
    const size_t hstep = (size_t)HALF * K * 2;
    const size_t tstep = 2 * hstep;
    const size_t hstepA = AROWS128 ? hstep / 2 : hstep;
    const unsigned ldsw = (unsigned)wid * 1024u;
    const int aoff = lds_byte(wr * 64 + fr, fq * 8), boff = lds_byte(wc * 32 + fr, fq * 8);
#define PG8_SA(b, h) (((b) * 2 + (h)) * HTB)
#define PG8_SB(b, h) ((4 + (b) * 2 + (h)) * HTB)
#define PG8_STAGE(bufoff, gbase, voff) do { _Pragma("unroll") for (int _i = 0; _i < 2; ++_i) \
        __builtin_amdgcn_global_load_lds((const unsigned*)((const char*)(gbase) + (voff)[_i]), (PG8_LAS unsigned*)(lds + (bufoff) + ldsw + _i * 8192), 16, 0, 0); } while (0)
#define PG8_LDA(dst, b, h) do { _Pragma("unroll") for (int m = 0; m < 4; ++m) _Pragma("unroll") for (int k = 0; k < 2; ++k) dst[m][k] = *(const PG8_LAS bf16x8*)(lds + PG8_SA(b, h) + aoff + m * 2048 + k * 1024); } while (0)
#define PG8_LDB(dst, b, h) do { _Pragma("unroll") for (int n = 0; n < 2; ++n) _Pragma("unroll") for (int k = 0; k < 2; ++k) dst[n][k] = *(const PG8_LAS bf16x8*)(lds + PG8_SB(b, h) + boff + n * 2048 + k * 1024); } while (0)
#define PG8_MMA(ai, bj, At, Bt) do { __builtin_amdgcn_s_setprio(1); _Pragma("unroll") for (int m = 0; m < 4; ++m) _Pragma("unroll") for (int n = 0; n < 2; ++n) _Pragma("unroll") for (int k = 0; k < 2; ++k) \
        acc[ai][bj][m][n] = __builtin_amdgcn_mfma_f32_16x16x32_bf16(Bt[n][k], At[m][k], acc[ai][bj][m][n], 0, 0, 0); __builtin_amdgcn_s_setprio(0); } while (0)
#define PG8_WAIT_V(n) asm volatile("s_waitcnt vmcnt(" #n ")" ::: "memory")
#define PG8_WAIT_L(n) asm volatile("s_waitcnt lgkmcnt(" #n ")" ::: "memory")
#define PG8_BAR __builtin_amdgcn_s_barrier()
#define PG8_SCHED __builtin_amdgcn_sched_barrier(0)
    Unit cur, nxt; int ui = 0;
    if (!S.next(0, cur)) return;
    f32x4 acc[2][2][4][2];
#pragma unroll
    for (int a = 0; a < 2; ++a)
#pragma unroll
        for (int b = 0; b < 2; ++b)
#pragma unroll
            for (int m = 0; m < 4; ++m)
#pragma unroll
                for (int n = 0; n < 2; ++n) acc[a][b][m][n] = (f32x4){0.f, 0.f, 0.f, 0.f};
    bf16x8 At[4][2], B0[2][2], B1[2][2];
    const char* cA = (const char*)g.A + (size_t)cur.pm * tstep; const char* cB = (const char*)g.Bt + (size_t)cur.pn * tstep;
    S.a_ready(cur);
    if constexpr (SP2) {
        PG8_STAGE(PG8_SB(0, 0), cB, voffB); PG8_STAGE(PG8_SB(0, 1), cB + hstep, voffB); PG8_STAGE(PG8_SA(0, 0), cA, voffA); PG8_STAGE(PG8_SA(0, 1), cA + hstepA, voffA);
        if (wr == 1) PG8_BAR;
        PG8_WAIT_V(2); PG8_BAR;
        PG8_STAGE(PG8_SB(1, 0), cB + kstep, voffB); PG8_STAGE(PG8_SA(1, 0), cA + kstep, voffA); PG8_STAGE(PG8_SB(1, 1), cB + hstep + kstep, voffB);
        PG8_WAIT_V(6); PG8_BAR;
    } else {
        PG8_STAGE(PG8_SB(0, 0), cB, voffB); PG8_STAGE(PG8_SA(0, 0), cA, voffA); PG8_STAGE(PG8_SB(0, 1), cB + hstep, voffB); PG8_STAGE(PG8_SA(0, 1), cA + hstepA, voffA);
        if (wr == 1) PG8_BAR;
        PG8_WAIT_V(4); PG8_BAR;
        PG8_STAGE(PG8_SB(1, 0), cB + kstep, voffB); PG8_STAGE(PG8_SA(1, 0), cA + kstep, voffA); PG8_STAGE(PG8_SB(1, 1), cB + hstep + kstep, voffB);
        PG8_WAIT_V(6); PG8_BAR;
    }
    for (;;) {
        const bool has_next = S.next(ui + 1, nxt);
        const char* nA = has_next ? (const char*)g.A + (size_t)nxt.pm * tstep : cA; const char* nB = has_next ? (const char*)g.Bt + (size_t)nxt.pn * tstep : cB;
        for (int t = 0; t < nt; t += 2) {
            const bool last = (t == nt - 2);
            const char* a1 = cA + (size_t)(t + 1) * kstep;
            const char* a2 = last ? nA : cA + (size_t)(t + 2) * kstep; const char* b2 = last ? nB : cB + (size_t)(t + 2) * kstep;
            const char* a3 = a2 + kstep; const char* b3 = b2 + kstep;
            if (last && has_next) S.a_ready(nxt);
            if constexpr (SP2) {
            PG8_LDB(B0, 0, 0); PG8_LDB(B1, 0, 1); PG8_SCHED; PG8_LDA(At, 0, 0); PG8_STAGE(PG8_SA(1, 1), a1 + hstepA, voffA);
            PG8_WAIT_V(8); PG8_WAIT_L(0); PG8_BAR; PG8_MMA(0, 0, At, B0); PG8_MMA(0, 1, At, B1); PG8_BAR; PG8_SCHED;
            PG8_LDA(At, 0, 1); PG8_STAGE(PG8_SB(0, 0), b2, voffB); PG8_STAGE(PG8_SB(0, 1), b2 + hstep, voffB); PG8_STAGE(PG8_SA(0, 0), a2, voffA);
            PG8_WAIT_V(8); PG8_WAIT_L(0); PG8_BAR; PG8_MMA(1, 0, At, B0); PG8_MMA(1, 1, At, B1); PG8_BAR; PG8_SCHED;
            PG8_LDB(B0, 1, 0); PG8_LDB(B1, 1, 1); PG8_SCHED; PG8_LDA(At, 1, 0); PG8_STAGE(PG8_SA(0, 1), a2 + hstepA, voffA);
            PG8_WAIT_V(8); PG8_WAIT_L(0); PG8_BAR; PG8_MMA(0, 0, At, B0); PG8_MMA(0, 1, At, B1); PG8_BAR; PG8_SCHED;
            PG8_LDA(At, 1, 1); PG8_STAGE(PG8_SB(1, 0), b3, voffB); PG8_STAGE(PG8_SB(1, 1), b3 + hstep, voffB); PG8_STAGE(PG8_SA(1, 0), a3, voffA);
            PG8_WAIT_V(8); PG8_WAIT_L(0); PG8_BAR; PG8_MMA(1, 0, At, B0); PG8_MMA(1, 1, At, B1); PG8_BAR; PG8_SCHED;
            } else {
            PG8_LDB(B0, 0, 0); PG8_SCHED; PG8_LDA(At, 0, 0); PG8_STAGE(PG8_SA(1, 1), a1 + hstepA, voffA);
            PG8_WAIT_L(8); PG8_BAR; PG8_WAIT_L(0); PG8_MMA(0, 0, At, B0); PG8_BAR; PG8_SCHED;
            PG8_LDB(B1, 0, 1); PG8_STAGE(PG8_SB(0, 0), b2, voffB);
            PG8_BAR; PG8_WAIT_L(0); PG8_MMA(0, 1, At, B1); PG8_BAR;
            PG8_LDA(At, 0, 1); PG8_STAGE(PG8_SA(0, 0), a2, voffA);
            PG8_BAR; PG8_WAIT_L(0); PG8_MMA(1, 0, At, B0); PG8_BAR; PG8_SCHED;
            PG8_STAGE(PG8_SB(0, 1), b2 + hstep, voffB);
            PG8_WAIT_V(6); PG8_BAR; PG8_MMA(1, 1, At, B1); PG8_BAR;
            PG8_LDB(B0, 1, 0); PG8_SCHED; PG8_LDA(At, 1, 0); PG8_STAGE(PG8_SA(0, 1), a2 + hstepA, voffA);
            PG8_WAIT_L(8); PG8_BAR; PG8_WAIT_L(0); PG8_MMA(0, 0, At, B0); PG8_BAR; PG8_SCHED;
            PG8_LDB(B1, 1, 1); PG8_STAGE(PG8_SB(1, 0), b3, voffB);
            PG8_BAR; PG8_WAIT_L(0); PG8_MMA(0, 1, At, B1); PG8_BAR;
            PG8_LDA(At, 1, 1); PG8_STAGE(PG8_SA(1, 0), a3, voffA);
            PG8_BAR; PG8_WAIT_L(0); PG8_MMA(1, 0, At, B0); PG8_BAR; PG8_SCHED;
            PG8_STAGE(PG8_SB(1, 1), b3 + hstep, voffB);
            PG8_WAIT_V(6); PG8_BAR; PG8_MMA(1, 1, At, B1); PG8_BAR;
            }
        }
        if constexpr (ALIGN_EPI) { if (wr == 0) PG8_BAR; }
        if constexpr (!Epi::AFTER_DRAIN) { E(acc, cur, wr, wc, fr, fq); S.done(cur); }
        if (!has_next) break;
#pragma unroll
        for (int a = 0; a < 2; ++a)
#pragma unroll
            for (int b = 0; b < 2; ++b)
#pragma unroll
                for (int m = 0; m < 4; ++m)
#pragma unroll
                    for (int n = 0; n < 2; ++n) acc[a][b][m][n] = (f32x4){0.f, 0.f, 0.f, 0.f};
        cur = nxt; cA = nA; cB = nB; ++ui;
        if constexpr (ALIGN_EPI) { if (wr == 1) PG8_BAR; }
    }
    PG8_WAIT_V(0);
    if constexpr (!ALIGN_EPI) { if (wr == 0) PG8_BAR; }
    PG8_BAR;
    if constexpr (Epi::AFTER_DRAIN) { E.fused(acc, cur, wr, wc, fr, fq, lds, wid, lane); S.done(cur); }
#undef PG8_SA
#undef PG8_SB
#undef PG8_STAGE
#undef PG8_LDA
#undef PG8_LDB
#undef PG8_MMA
#undef PG8_WAIT_V
#undef PG8_WAIT_L
#undef PG8_BAR
#undef PG8_SCHED
}
}

constexpr int DM = 1024, NPROMPT = 32768, NSAMPLE = 16384, MROWS = NPROMPT + NSAMPLE;
constexpr int SP = 2048, SS = 16384;
constexpr int LDP = 3328;
constexpr int C_DAQ = 0, C_DAK = 512, C_DAV = 1024, C_GQ = 1536, C_GK = 1792, C_GV = 2048, C_GR = 2560, C_LRF = 3072, C_LRB = 3088;
constexpr int DFF = 4096, NFIXROWS = 1536, NMAINT = MROWS / 256, NGRP = MROWS / 128;
constexpr float EPS = 1e-6f;
constexpr int NCHUNK = MROWS / 64;
constexpr size_t MiB = 1u << 20;
constexpr size_t WS_CTL = 0, WS_WUP = 1 * MiB, WS_WDOWN = 17 * MiB, WS_H = 25 * MiB, WS_ACT = 127 * MiB, WS_END = 511 * MiB;
constexpr size_t WS_PROJ = WS_ACT, WS_WIN = 439 * MiB, WS_WOUT = 446 * MiB, WS_DEC = 448 * MiB, WS_MIX = WS_ACT;
constexpr size_t WS_X2B = WS_ACT, WS_PB = 223 * MiB, WS_WGATE = 247 * MiB, WS_WPROJ = 249 * MiB, WS_GOUT = 250 * MiB, WS_EOUT = 346 * MiB;
constexpr size_t WS_WGT = 65536;
constexpr int CW_QCTR = 0, CW_LAM = 64, CW_NORM = 128, CW_BAR = 1024;
constexpr int CTL_ZERO_BYTES = 32768;
constexpr int RING_BYTES = 131072, MISC_OFF = RING_BYTES, LDS_BYTES = 147456;
constexpr int NWAVES = 8;

#define LAS __attribute__((address_space(3)))
typedef unsigned short bf16;
typedef unsigned v4u __attribute__((ext_vector_type(4)));
typedef unsigned v2u __attribute__((ext_vector_type(2)));
typedef float f32x4 __attribute__((ext_vector_type(4)));
typedef short bf16x8 __attribute__((ext_vector_type(8)));
typedef short s16x4 __attribute__((ext_vector_type(4)));
typedef float f32x16 __attribute__((ext_vector_type(16)));

__device__ __forceinline__ unsigned f2bf(float f) { unsigned u = __builtin_bit_cast(unsigned, f); return (u + 0x7fffu + ((u >> 16) & 1u)) >> 16; }
__device__ __forceinline__ unsigned pk2(float lo, float hi) { return f2bf(lo) | (f2bf(hi) << 16); }
__device__ __forceinline__ float bf2f(unsigned short b) { return __builtin_bit_cast(float, (unsigned)b << 16); }
__device__ __forceinline__ float bflo(unsigned w) { return __builtin_bit_cast(float, w << 16); }
__device__ __forceinline__ float bfhi(unsigned w) { return __builtin_bit_cast(float, w & 0xffff0000u); }
#define DPPF(v, ctrl, rmask) __builtin_bit_cast(float, __builtin_amdgcn_update_dpp(0, __builtin_bit_cast(int, (float)(v)), ctrl, rmask, 0xf, false))
__device__ __forceinline__ float wave_sum(float v) {
    v += DPPF(v, 0xB1, 0xf); v += DPPF(v, 0x4E, 0xf); v += DPPF(v, 0x141, 0xf); v += DPPF(v, 0x140, 0xf);
    v += DPPF(v, 0x142, 0xa); v += DPPF(v, 0x143, 0xc);
    return __builtin_bit_cast(float, __builtin_amdgcn_readlane(__builtin_bit_cast(int, v), 63));
}
__device__ __forceinline__ int crow(int r, int hi) { return (r & 3) + 8 * (r >> 2) + 4 * hi; }

struct Args {
    const float* in[28]; float* out; unsigned char* ws;
};

__device__ __forceinline__ void transpose_item(const float* W, int K, int N, bf16* WT, int k0, int n0src, int n0dst, LAS float* scr, int lane) {
#pragma unroll 8
    for (int i = 0; i < 32; ++i) { const int kk = 2 * i + (lane >> 5); scr[kk * 33 + (lane & 31)] = __builtin_nontemporal_load(W + (size_t)(k0 + kk) * N + n0src + (lane & 31)); }
    asm volatile("s_waitcnt lgkmcnt(0)" ::: "memory");
    const int c = lane & 7;
#pragma unroll
    for (int j = 0; j < 4; ++j) { const int n = (lane >> 3) + 8 * j; const LAS float* s = scr + (8 * c) * 33 + n;
        v4u o; o.x = pk2(s[0 * 33], s[1 * 33]); o.y = pk2(s[2 * 33], s[3 * 33]); o.z = pk2(s[4 * 33], s[5 * 33]); o.w = pk2(s[6 * 33], s[7 * 33]);
        *(v4u*)(WT + (size_t)(n0dst + n) * K + k0 + 8 * c) = o; }
    asm volatile("s_waitcnt lgkmcnt(0)" ::: "memory");
}
__device__ __forceinline__ const float* xrow_ptr(const Args& a, int row) { return row < NPROMPT ? a.in[0] + (size_t)row * DM : a.in[1] + (size_t)(row - NPROMPT) * DM; }
__device__ __forceinline__ const float* prow_ptr(const Args& a, int row) { return row < NPROMPT ? a.in[2] + (size_t)row * 256 : a.in[3] + (size_t)(row - NPROMPT) * 256; }

namespace da {
constexpr int SHM_V = 16384, SHM_K = 16384;
constexpr float THRL = 0.0f;
#define KSWZ(row, colB) ((row) * 256 + ((colB) ^ (((row) & 7) << 4)))
#define SBAR() __builtin_amdgcn_sched_barrier(0)
__device__ __forceinline__ unsigned cvtpk(float lo, float hi) { unsigned r; asm volatile("v_cvt_pk_bf16_f32 %0, %1, %2" : "=v"(r) : "v"(lo), "v"(hi)); return r; }
#define PK4(P, BASE, OUT) do { unsigned a0 = cvtpk(P[BASE + 0], P[BASE + 1]), a1 = cvtpk(P[BASE + 2], P[BASE + 3]);   \
    unsigned b0 = cvtpk(P[BASE + 4], P[BASE + 5]), b1 = cvtpk(P[BASE + 6], P[BASE + 7]);                              \
    auto r0 = __builtin_amdgcn_permlane32_swap(a0, b0, false, false); auto r1 = __builtin_amdgcn_permlane32_swap(a1, b1, false, false); \
    v4u w = {r0[0], r1[0], r0[1], r1[1]}; OUT = *reinterpret_cast<bf16x8*>(&w); } while (0)
__device__ __forceinline__ void sc_init(f32x16& p0, f32x16& p1, float dq, float nsl2, float m_ref, int side) {
  if (side != 0) { const float sg = (float)side; const float base0 = fmaf(sg * nsl2, dq, -m_ref), base1 = base0 - sg * 32.f * nsl2;
#pragma unroll
    for (int r = 0; r < 16; ++r) { const float c = -sg * nsl2 * (float)((r & 3) + 8 * (r >> 2)); p0[r] = base0 + c; p1[r] = base1 + c; }
  } else {
#pragma unroll
    for (int r = 0; r < 16; ++r) { const float kv = (float)((r & 3) + 8 * (r >> 2)); const float d0 = dq - kv, d1 = d0 - 32.f;
      p0[r] = fmaf(nsl2, __builtin_fabsf(d0), -m_ref); p1[r] = fmaf(nsl2, __builtin_fabsf(d1), -m_ref); }
  }
}
#define KFRAG(d0, which) (*reinterpret_cast<const bf16x8*>(Ks + KSWZ((which) * 32 + r32, (cbase + (d0) * 16 + hi * 8) * 2)))
__device__ __forceinline__ void qk_only(f32x16& p0, f32x16& p1, const char* Ks, const bf16x8* qr, int r32, int hi, int cbase) {
#pragma unroll
  for (int d0 = 0; d0 < 4; ++d0) { const bf16x8 b0 = KFRAG(d0, 0), b1 = KFRAG(d0, 1);
    p0 = __builtin_amdgcn_mfma_f32_32x32x16_bf16(b0, qr[d0], p0, 0, 0, 0); p1 = __builtin_amdgcn_mfma_f32_32x32x16_bf16(b1, qr[d0], p1, 0, 0, 0); }
}
__device__ __forceinline__ void qk_fin(f32x16& n0, f32x16& n1, const char* Ks, const bf16x8* qr, int r32, int hi, int cbase,
                                       const f32x16& q0, const f32x16& q1, float& l_reg, bf16x8& pa0, bf16x8& pa1, bf16x8& pa2, bf16x8& pa3) {
  bf16x8 ka0 = KFRAG(0, 0), ka1 = KFRAG(0, 1), kb0 = KFRAG(1, 0), kb1 = KFRAG(1, 1); float ps = 0.f;
  n0 = __builtin_amdgcn_mfma_f32_32x32x16_bf16(ka0, qr[0], n0, 0, 0, 0); n1 = __builtin_amdgcn_mfma_f32_32x32x16_bf16(ka1, qr[0], n1, 0, 0, 0);
  ka0 = KFRAG(2, 0); ka1 = KFRAG(2, 1);
#pragma unroll
  for (int r = 0; r < 8; ++r) ps += q0[r];
  PK4(q0, 0, pa0); asm volatile("" : "+v"(pa0), "+v"(ps)); SBAR();
  n0 = __builtin_amdgcn_mfma_f32_32x32x16_bf16(kb0, qr[1], n0, 0, 0, 0); n1 = __builtin_amdgcn_mfma_f32_32x32x16_bf16(kb1, qr[1], n1, 0, 0, 0);
  kb0 = KFRAG(3, 0); kb1 = KFRAG(3, 1);
#pragma unroll
  for (int r = 8; r < 16; ++r) ps += q0[r];
  PK4(q0, 8, pa1); asm volatile("" : "+v"(pa1), "+v"(ps)); SBAR();
  n0 = __builtin_amdgcn_mfma_f32_32x32x16_bf16(ka0, qr[2], n0, 0, 0, 0); n1 = __builtin_amdgcn_mfma_f32_32x32x16_bf16(ka1, qr[2], n1, 0, 0, 0);
#pragma unroll
  for (int r = 0; r < 8; ++r) ps += q1[r];
  PK4(q1, 0, pa2); asm volatile("" : "+v"(pa2), "+v"(ps)); SBAR();
  n0 = __builtin_amdgcn_mfma_f32_32x32x16_bf16(kb0, qr[3], n0, 0, 0, 0); n1 = __builtin_amdgcn_mfma_f32_32x32x16_bf16(kb1, qr[3], n1, 0, 0, 0);
#pragma unroll
  for (int r = 8; r < 16; ++r) ps += q1[r];
  PK4(q1, 8, pa3);
  { auto rr = __builtin_amdgcn_permlane32_swap(__float_as_uint(ps), __float_as_uint(ps), false, false); ps = __uint_as_float(rr[0]) + __uint_as_float(rr[1]); }
  l_reg += ps; SBAR();
}
__device__ __forceinline__ void fin_only(const f32x16& q0, const f32x16& q1, float& l_reg, bf16x8& pa0, bf16x8& pa1, bf16x8& pa2, bf16x8& pa3) {
  float ps = 0.f;
#pragma unroll
  for (int r = 0; r < 16; ++r) ps += q0[r];
#pragma unroll
  for (int r = 0; r < 16; ++r) ps += q1[r];
  { auto rr = __builtin_amdgcn_permlane32_swap(__float_as_uint(ps), __float_as_uint(ps), false, false); ps = __uint_as_float(rr[0]) + __uint_as_float(rr[1]); }
  l_reg += ps; PK4(q0, 0, pa0); PK4(q0, 8, pa1); PK4(q1, 0, pa2); PK4(q1, 8, pa3);
}
__device__ __forceinline__ int v_st(int k, int c) { const int kk = (k & ~0xC) | ((k & 4) << 1) | ((k & 8) >> 1); return ((kk >> 3) * 4 + (c >> 5)) * 512 + ((kk & 7) * 32 + (c & 31)) * 2; }
__device__ __forceinline__ int v_rd_base(int lane) { return ((lane & 3) << 3) | (((lane >> 2) & 3) << 6) | (((lane >> 4) & 1) << 5) | (((lane >> 5) & 1) << 8); }
constexpr int v_rd_off(int d0, int ks, int half) { return d0 * 512 + ks * 4096 + half * 2048; }
template <int OFF> __device__ __forceinline__ s16x4 tr_read(int vb) {
  s16x4 r; asm volatile("ds_read_b64_tr_b16 %0, %1 offset:%2" : "=&v"(r) : "v"(vb), "i"(OFF) : "memory"); return r;
}
template <int D0> __device__ __forceinline__ void pv_one(f32x16& od, int vb, bf16x8 pa0, bf16x8 pa1, bf16x8 pa2, bf16x8 pa3) {
  const s16x4 l0 = tr_read<v_rd_off(D0, 0, 0)>(vb), h0 = tr_read<v_rd_off(D0, 0, 1)>(vb), l1 = tr_read<v_rd_off(D0, 1, 0)>(vb), h1 = tr_read<v_rd_off(D0, 1, 1)>(vb);
  const s16x4 l2 = tr_read<v_rd_off(D0, 2, 0)>(vb), h2 = tr_read<v_rd_off(D0, 2, 1)>(vb), l3 = tr_read<v_rd_off(D0, 3, 0)>(vb), h3 = tr_read<v_rd_off(D0, 3, 1)>(vb);
  asm volatile("s_waitcnt lgkmcnt(0)" ::: "memory"); SBAR();
#define PK(L, H) (bf16x8){L[0], L[1], L[2], L[3], H[0], H[1], H[2], H[3]}
  od = __builtin_amdgcn_mfma_f32_32x32x16_bf16(pa0, PK(l0, h0), od, 0, 0, 0);
  od = __builtin_amdgcn_mfma_f32_32x32x16_bf16(pa1, PK(l1, h1), od, 0, 0, 0);
  od = __builtin_amdgcn_mfma_f32_32x32x16_bf16(pa2, PK(l2, h2), od, 0, 0, 0);
  od = __builtin_amdgcn_mfma_f32_32x32x16_bf16(pa3, PK(l3, h3), od, 0, 0, 0);
#undef PK
}
__device__ __forceinline__ void pv_exp(f32x16* o, int vb, bf16x8 pa0, bf16x8 pa1, bf16x8 pa2, bf16x8 pa3, f32x16& n0, f32x16& n1) {
  pv_one<0>(o[0], vb, pa0, pa1, pa2, pa3);
#pragma unroll
  for (int r = 0; r < 8; ++r) n0[r] = __builtin_amdgcn_exp2f(n0[r]);
  asm volatile("" : "+v"(n0)); SBAR(); pv_one<1>(o[1], vb, pa0, pa1, pa2, pa3);
#pragma unroll
  for (int r = 8; r < 16; ++r) n0[r] = __builtin_amdgcn_exp2f(n0[r]);
  asm volatile("" : "+v"(n0)); SBAR(); pv_one<2>(o[2], vb, pa0, pa1, pa2, pa3);
#pragma unroll
  for (int r = 0; r < 8; ++r) n1[r] = __builtin_amdgcn_exp2f(n1[r]);
  asm volatile("" : "+v"(n1)); SBAR(); pv_one<3>(o[3], vb, pa0, pa1, pa2, pa3);
#pragma unroll
  for (int r = 8; r < 16; ++r) n1[r] = __builtin_amdgcn_exp2f(n1[r]);
  asm volatile("" : "+v"(n1)); SBAR();
}
__device__ __forceinline__ void pv_d0(f32x16* o, int vb, bf16x8 pa0, bf16x8 pa1, bf16x8 pa2, bf16x8 pa3) {
  pv_one<0>(o[0], vb, pa0, pa1, pa2, pa3); pv_one<1>(o[1], vb, pa0, pa1, pa2, pa3); pv_one<2>(o[2], vb, pa0, pa1, pa2, pa3); pv_one<3>(o[3], vb, pa0, pa1, pa2, pa3);
}
__device__ __forceinline__ void attn_unit(const bf16* __restrict__ P, bf16* __restrict__ MIXIN, const float* __restrict__ gn, int seq0, int h, int q0, int nt, float kmax0, float kmax1, float slope, float lam, char* lds) {
  int tid_ = threadIdx.x; asm volatile("" : "+v"(tid_)); const int tid = tid_, wid = tid >> 6, lane = tid & 63, r32 = lane & 31, hi = lane >> 5, mp = wid >> 2, wq = wid & 3;
  char* V_lds = lds; char* K_lds = lds + 3 * SHM_V;
  float* ws = (float*)(lds + 3 * SHM_V + 3 * SHM_K) + wid * 64; float* li_l = ws; float* al_l = ws + 32;
  float l_reg = 0; f32x16 o[4] = {}; bf16x8 qr[4];
  const int qpos = q0 + wq * 32 + r32;
  const bf16* Qw = P + (size_t)(seq0 + qpos) * LDP + C_DAQ + h * 128 + mp * 64 + hi * 8;
#pragma unroll
  for (int d0 = 0; d0 < 4; ++d0) qr[d0] = *reinterpret_cast<const bf16x8*>(Qw + d0 * 16);
  const bf16* Kh = P + (size_t)seq0 * LDP + C_DAK + h * 128;
  int t0, t1; float m_reg;
  { const bf16* Kw = Kh + (size_t)qpos * LDP + mp * 64 + hi * 8; float qn = 0.f, sd = 0.f;
#pragma unroll
    for (int d0 = 0; d0 < 4; ++d0) { const bf16x8 kf = *reinterpret_cast<const bf16x8*>(Kw + d0 * 16);
#pragma unroll
      for (int e = 0; e < 8; ++e) { const float qv = bf2f((unsigned short)qr[d0][e]), kv = bf2f((unsigned short)kf[e]); qn += qv * qv; sd += qv * kv; } }
    qn += __shfl_xor(qn, 32); sd += __shfl_xor(sd, 32);
    const float ub = sqrtf(qn) * (mp ? kmax1 : kmax0) * 1.0001f;
    m_reg = fminf(ub, sd + 60.f);
    float bnd = ub - sd;
    bnd = fmaxf(bnd, __shfl_xor(bnd, 1)); bnd = fmaxf(bnd, __shfl_xor(bnd, 2)); bnd = fmaxf(bnd, __shfl_xor(bnd, 4)); bnd = fmaxf(bnd, __shfl_xor(bnd, 8)); bnd = fmaxf(bnd, __shfl_xor(bnd, 16));
    float* wsb = (float*)(lds + 3 * SHM_V + 3 * SHM_K);
    if (lane == 0) wsb[wid] = bnd;
    __syncthreads();
    float B = wsb[0];
#pragma unroll
    for (int w = 1; w < 8; ++w) B = fmaxf(B, wsb[w]);
    const float Wf = fminf((B + 24.f * 1.4426950408889634f) / (slope * 1.4426950408889634f) + 1.f, 1.0e6f); const int Wi = (int)Wf;
    const int lo = q0 - Wi, hi_ = q0 + 127 + Wi;
    t0 = lo > 0 ? (lo >> 6) : 0; t1 = (hi_ >> 6) + 1; if (t1 > nt) t1 = nt;
    if ((t1 - t0) & 1) { if (t0 > 0) --t0; else ++t1; }
    __syncthreads(); }
  const bf16* Vh = P + (size_t)seq0 * LDP + C_DAV + h * 128;
  const int sr = tid >> 4, sc = (tid & 15) * 8, vst0 = v_st(sr, sc), vst1 = v_st(32 + sr, sc);
  const int vb0 = (int)(uintptr_t)V_lds + v_rd_base(lane);
  const float nsl2 = -slope * 1.4426950408889634f;
  const float dqb = (float)(qpos - 4 * hi);
  const int cbase = mp * 64;
  const int jlo_ = q0 >> 6, jhi_ = (q0 + 127) >> 6;
  bf16x8 vsA0, vsA1, ksA0, ksA1;
#define SLOADA(k0) do { vsA0 = *(const bf16x8*)(&Vh[(size_t)((k0) + sr) * LDP + sc]); vsA1 = *(const bf16x8*)(&Vh[(size_t)((k0) + 32 + sr) * LDP + sc]); \
    ksA0 = *(const bf16x8*)(&Kh[(size_t)((k0) + sr) * LDP + sc]); ksA1 = *(const bf16x8*)(&Kh[(size_t)((k0) + 32 + sr) * LDP + sc]); } while (0)
#define SLOADB(k0) do { vsB0 = *(const bf16x8*)(&Vh[(size_t)((k0) + sr) * LDP + sc]); vsB1 = *(const bf16x8*)(&Vh[(size_t)((k0) + 32 + sr) * LDP + sc]); \
    ksB0 = *(const bf16x8*)(&Kh[(size_t)((k0) + sr) * LDP + sc]); ksB1 = *(const bf16x8*)(&Kh[(size_t)((k0) + 32 + sr) * LDP + sc]); } while (0)
#define SWRITEA(b) do { *(bf16x8*)(V_lds + (b) * SHM_V + vst0) = vsA0; *(bf16x8*)(V_lds + (b) * SHM_V + vst1) = vsA1; const int kc = sc * 2; \
    *(bf16x8*)(K_lds + (b) * SHM_K + KSWZ(sr, kc)) = ksA0; *(bf16x8*)(K_lds + (b) * SHM_K + KSWZ(32 + sr, kc)) = ksA1; } while (0)
#define SWRITEB(b) do { *(bf16x8*)(V_lds + (b) * SHM_V + vst0) = vsB0; *(bf16x8*)(V_lds + (b) * SHM_V + vst1) = vsB1; const int kc = sc * 2; \
    *(bf16x8*)(K_lds + (b) * SHM_K + KSWZ(sr, kc)) = ksB0; *(bf16x8*)(K_lds + (b) * SHM_K + KSWZ(32 + sr, kc)) = ksB1; } while (0)
#define SWAIT() asm volatile("s_waitcnt vmcnt(4)" ::: "memory")
#define RESC(a) do { if (__any((a) < 1.f)) { if (hi == 0) al_l[r32] = (a); asm volatile("s_waitcnt lgkmcnt(0)" ::: "memory"); \
    _Pragma("unroll") for (int d = 0; d < 4; ++d) _Pragma("unroll") for (int r = 0; r < 16; ++r) o[d][r] *= al_l[crow(r, hi)]; } } while (0)
#define DQ(j) (dqb - 64.f * (float)(j))
#define SIDE(j) (((j) < jlo_) ? 1 : (((j) > jhi_) ? -1 : 0))
  f32x16 pA0, pA1, pB0, pB1; bf16x8 pa0, pa1, pa2, pa3;
  SLOADA(t0 * 64); asm volatile("s_waitcnt vmcnt(0)" ::: "memory"); SWRITEA(0); __syncthreads();
  SLOADA((t0 + 1) * 64);
  sc_init(pA0, pA1, DQ(t0), nsl2, m_reg, SIDE(t0)); qk_only(pA0, pA1, K_lds, qr, r32, hi, cbase);
#pragma unroll
  for (int r = 0; r < 16; ++r) { pA0[r] = __builtin_amdgcn_exp2f(pA0[r]); pA1[r] = __builtin_amdgcn_exp2f(pA1[r]); }
  asm volatile("s_waitcnt vmcnt(0)" ::: "memory"); SWRITEA(1); __syncthreads();
  int slp = 0, slc = 1, sln = 2;
  for (int j = t0 + 1; j + 1 < t1; j += 2) {
    SLOADA((j + 1) * 64); SBAR();
    sc_init(pB0, pB1, DQ(j), nsl2, m_reg, SIDE(j)); SBAR();
    qk_fin(pB0, pB1, K_lds + slc * SHM_K, qr, r32, hi, cbase, pA0, pA1, l_reg, pa0, pa1, pa2, pa3);
    pv_exp(o, vb0 + slp * SHM_V, pa0, pa1, pa2, pa3, pB0, pB1);
    asm volatile("s_waitcnt vmcnt(0)" ::: "memory"); SWRITEA(sln); __syncthreads();
    { const int t_ = slp; slp = slc; slc = sln; sln = t_; }
    if (j + 2 < t1) SLOADA((j + 2) * 64); SBAR();
    sc_init(pA0, pA1, DQ(j + 1), nsl2, m_reg, SIDE(j + 1)); SBAR();
    qk_fin(pA0, pA1, K_lds + slc * SHM_K, qr, r32, hi, cbase, pB0, pB1, l_reg, pa0, pa1, pa2, pa3);
    pv_exp(o, vb0 + slp * SHM_V, pa0, pa1, pa2, pa3, pA0, pA1);
    if (j + 2 < t1) { asm volatile("s_waitcnt vmcnt(0)" ::: "memory"); SWRITEA(sln); } __syncthreads();
    { const int t_ = slp; slp = slc; slc = sln; sln = t_; }
  }
  sc_init(pB0, pB1, DQ(t1 - 1), nsl2, m_reg, SIDE(t1 - 1)); SBAR();
  qk_fin(pB0, pB1, K_lds + slc * SHM_K, qr, r32, hi, cbase, pA0, pA1, l_reg, pa0, pa1, pa2, pa3);
  pv_exp(o, vb0 + slp * SHM_V, pa0, pa1, pa2, pa3, pB0, pB1);
  fin_only(pB0, pB1, l_reg, pa0, pa1, pa2, pa3); SBAR();
  pv_d0(o, vb0 + slc * SHM_V, pa0, pa1, pa2, pa3);
  int tide_ = threadIdx.x; asm volatile("" : "+v"(tide_)); const int lanee = tide_ & 63, r32e = lanee & 31, hie = lanee >> 5, wide = tide_ >> 6, wqe = wide & 3, mpe = wide >> 2;
  if (hie == 0) li_l[r32e] = l_reg; asm volatile("s_waitcnt lgkmcnt(0)" ::: "memory");
  float rli[16];
#pragma unroll
  for (int r = 0; r < 16; ++r) rli[r] = __builtin_amdgcn_rcpf(li_l[crow(r, hie)]);
  asm volatile("s_waitcnt vmcnt(0)" ::: "memory");
  __syncthreads();
  float* X = (float*)lds;
  if (mpe == 1) {
#pragma unroll
    for (int d0 = 0; d0 < 4; ++d0)
#pragma unroll
      for (int r = 0; r < 16; ++r) X[(wqe * 64 + d0 * 16 + r) * 64 + lanee] = o[d0][r] * rli[r] * lam;
  }
  __syncthreads();
  if (mpe == 0) {
    float g4[4];
#pragma unroll
    for (int d0 = 0; d0 < 4; ++d0) g4[d0] = gn[d0 * 32 + r32e] * 0.8f;
#pragma unroll
    for (int d0 = 0; d0 < 4; ++d0)
#pragma unroll
      for (int r = 0; r < 16; ++r) o[d0][r] = o[d0][r] * rli[r] - X[(wqe * 64 + d0 * 16 + r) * 64 + lanee];
    bf16* Ow = MIXIN + (size_t)(seq0 + q0 + wqe * 32) * DM + h * 128 + r32e;
#pragma unroll
    for (int r = 0; r < 16; ++r) {
      float ss = o[0][r] * o[0][r] + o[1][r] * o[1][r] + o[2][r] * o[2][r] + o[3][r] * o[3][r];
      ss += __shfl_xor(ss, 1); ss += __shfl_xor(ss, 2); ss += __shfl_xor(ss, 4); ss += __shfl_xor(ss, 8); ss += __shfl_xor(ss, 16);
      const float sc_ = 1.0f / sqrtf(ss * (1.0f / 128.0f) + EPS);
      const int orow = crow(r, hie);
#pragma unroll
      for (int d0 = 0; d0 < 4; ++d0) Ow[(size_t)orow * DM + d0 * 32] = (bf16)f2bf(o[d0][r] * sc_ * g4[d0]);
    }
  }
  __syncthreads();
#undef SLOADA
#undef SLOADB
#undef SWRITEA
#undef SWRITEB
#undef SWAIT
#undef RESC
#undef DQ
#undef SIDE
}
}

namespace gla {
#define LBAR() do { asm volatile("s_waitcnt lgkmcnt(0)" ::: "memory"); __builtin_amdgcn_s_barrier(); asm volatile("" ::: "memory"); } while (0)
constexpr int GS = 68;
constexpr int VS = 272;
constexpr int ST72 = 72;
constexpr int L_BD = 0, L_ATTF = 0, L_ATTB = 9216, L_V = 34816, L_SF = 52224, L_SB = 69632, L_QTF = 87040, L_QTB = 96256, L_KTF = 105472, L_KTB = 114688, L_RS = 123904;
typedef LAS const char* lcp;
typedef short v4i16_t __attribute__((ext_vector_type(4)));
__device__ __forceinline__ bf16x8 frag(lcp base, int row0, int k0, int lane) { return *(LAS const bf16x8*)(base + ((row0 + (lane & 31)) * ST72 + k0 + 8 * (lane >> 5)) * 2); }
__device__ __forceinline__ s16x4 tr4(lcp p) { return __builtin_bit_cast(s16x4, __builtin_amdgcn_ds_read_tr16_b64_v4i16((LAS v4i16_t*)p)); }
__device__ __forceinline__ bf16x8 trfrag(lcp base, int rs, int k0, int n0, int lane) {
  const int g = lane >> 4, r = (lane & 15) >> 2, c = lane & 3;
  lcp p = base + (k0 + 8 * (g >> 1) + r) * rs + (n0 + 16 * (g & 1) + 4 * c) * 2;
  const s16x4 lo = tr4(p), hi = tr4(p + 4 * rs);
  return (bf16x8){lo[0], lo[1], lo[2], lo[3], hi[0], hi[1], hi[2], hi[3]};
}
__device__ __forceinline__ float logsig(float z) { return fminf(z, 0.f) - __logf(1.0f + __expf(-__builtin_fabsf(z))); }
struct GPre { v4u kk, qq; v4u vv[4]; v4u sfv[4], sbv[4]; bf16x8 lr0, lr1, wb; float bias; unsigned short grv[16]; };
template <bool G3>
__device__ __forceinline__ void load_pre(GPre& R, const bf16* __restrict__ P, const Args& a, const bf16* __restrict__ WGT, const bf16* __restrict__ STATE, int n, int h) {
  int tid_ = threadIdx.x; asm volatile("" : "+v"(tid_)); const int tid = tid_, lane = tid & 63, wid = __builtin_amdgcn_readfirstlane(tid >> 6), r32 = lane & 31, hi = lane >> 5, row0 = n * 64, s = tid >> 3, dg = tid & 7;
  R.kk = *(const v4u*)(P + (size_t)(row0 + s) * LDP + C_GK + h * 64 + dg * 8);
  if (G3) { R.qq = *(const v4u*)(P + (size_t)(row0 + s) * LDP + C_GQ + h * 64 + dg * 8);
    const int ct_ = wid >> 2, et_ = wid & 3;
#pragma unroll
    for (int r = 0; r < 16; ++r) R.grv[r] = P[(size_t)(row0 + 32 * ct_ + crow(r, hi)) * LDP + C_GR + h * 128 + 32 * et_ + r32]; }
  if (wid < 4) { const int dir = wid >> 1, dt = wid & 1, c = h * 64 + 32 * dt + r32;
    R.wb = *(const bf16x8*)(WGT + ((size_t)dir * 256 + c) * 16 + 8 * hi); R.bias = (dir ? a.in[14] : a.in[12])[c];
    R.lr0 = *(const bf16x8*)(P + (size_t)(row0 + r32) * LDP + (dir ? C_LRB : C_LRF) + 8 * hi); R.lr1 = *(const bf16x8*)(P + (size_t)(row0 + 32 + r32) * LDP + (dir ? C_LRB : C_LRF) + 8 * hi);
  } else { const int t = tid - 256, s2 = t >> 2, part = t & 3;
    { const v4u* src = (const v4u*)(P + (size_t)(row0 + s2) * LDP + C_GV + h * 128 + part * 32); R.vv[0] = src[0]; R.vv[1] = src[1]; R.vv[2] = src[2]; R.vv[3] = src[3]; }
    if (G3) { const v4u* sf = (const v4u*)(STATE + ((size_t)(0 * NCHUNK + n) * 4 + h) * 8192 + s2 * 128 + part * 32); const v4u* sb = (const v4u*)(STATE + ((size_t)(1 * NCHUNK + n) * 4 + h) * 8192 + s2 * 128 + part * 32);
#pragma unroll
      for (int i = 0; i < 4; ++i) { R.sfv[i] = sf[i]; R.sbv[i] = sb[i]; } }
  }
}
template <bool WITH_S>
__device__ __forceinline__ void prep(const GPre& R, int n, int h, LAS char* lds) {
  int tid_ = threadIdx.x; asm volatile("" : "+v"(tid_)); const int tid = tid_, lane = tid & 63, wid = __builtin_amdgcn_readfirstlane(tid >> 6), r32 = lane & 31, hi = lane >> 5, row0 = n * 64;
  if (wid < 4) {
    const int dir = wid >> 1, dt = wid & 1;
    const bf16x8 bfr = R.wb;
    const float bias = R.bias;
    float g[32];
#pragma unroll
    for (int st = 0; st < 2; ++st) { const bf16x8 afr = st ? R.lr1 : R.lr0;
      f32x16 z = {}; z = __builtin_amdgcn_mfma_f32_32x32x16_bf16(afr, bfr, z, 0, 0, 0);
#pragma unroll
      for (int r = 0; r < 16; ++r) g[16 * st + r] = logsig(z[r] + bias) * 0.0625f; }
    float T[8], Tp[8];
    if (dir == 0) {
#pragma unroll
      for (int i = 0; i < 8; ++i) { g[4 * i + 1] += g[4 * i]; g[4 * i + 2] += g[4 * i + 1]; g[4 * i + 3] += g[4 * i + 2]; T[i] = g[4 * i + 3]; }
    } else {
#pragma unroll
      for (int i = 0; i < 8; ++i) { g[4 * i + 2] += g[4 * i + 3]; g[4 * i + 1] += g[4 * i + 2]; g[4 * i] += g[4 * i + 1]; T[i] = g[4 * i]; }
    }
#pragma unroll
    for (int i = 0; i < 8; ++i) Tp[i] = __shfl_xor(T[i], 32);
    if (dir == 0) { float run = 0.f;
#pragma unroll
      for (int i = 0; i < 8; ++i) { const float E = run + (hi ? Tp[i] : 0.f); run += T[i] + Tp[i];
#pragma unroll
        for (int q = 0; q < 4; ++q) g[4 * i + q] += E; }
    } else { float run = 0.f;
#pragma unroll
      for (int i = 7; i >= 0; --i) { const float E = run + (hi ? 0.f : Tp[i]); run += T[i] + Tp[i];
#pragma unroll
        for (int q = 0; q < 4; ++q) g[4 * i + q] += E; }
    }
    LAS float* B = (LAS float*)(lds + L_BD) + dir * 64 * GS + 32 * dt + r32;
#pragma unroll
    for (int i = 0; i < 8; ++i)
#pragma unroll
      for (int q = 0; q < 4; ++q) { const int s = 32 * (i >> 2) + q + 8 * (i & 3) + 4 * hi; B[s * GS] = g[4 * i + q]; }
  } else {
    const int t = tid - 256, s = t >> 2, part = t & 3;
    { LAS v4u* dst = (LAS v4u*)(lds + L_V + s * VS + part * 64); dst[0] = R.vv[0]; dst[1] = R.vv[1]; dst[2] = R.vv[2]; dst[3] = R.vv[3]; }
    if (WITH_S) { LAS v4u* df = (LAS v4u*)(lds + L_SF + s * VS + part * 64); LAS v4u* db = (LAS v4u*)(lds + L_SB + s * VS + part * 64);
#pragma unroll
      for (int i = 0; i < 4; ++i) { df[i] = R.sfv[i]; db[i] = R.sbv[i]; } }
  }
  LBAR();
}
__device__ __forceinline__ void g1_unit(const GPre& R, bf16* __restrict__ STATE, float* __restrict__ DEC, int n, int h, LAS char* lds) {
  int tid_ = threadIdx.x; asm volatile("" : "+v"(tid_)); const int tid = tid_, lane = tid & 63, wid = __builtin_amdgcn_readfirstlane(tid >> 6), s = tid >> 3, dg = tid & 7, row0 = n * 64;
  const v4u kk = R.kk;
  prep<false>(R, n, h, lds);
  { const LAS float* Bf = (const LAS float*)(lds + L_BD); const LAS float* Bb = Bf + 64 * GS;
    float kef[8], keb[8];
#pragma unroll
    for (int j = 0; j < 8; ++j) { const int d = dg * 8 + j; const float kv = (j & 1) ? bfhi(kk[j >> 1]) : bflo(kk[j >> 1]);
      const float bl = Bf[63 * GS + d], b0 = Bb[d];
      kef[j] = kv * __expf(bl - Bf[s * GS + d]); keb[j] = kv * __expf(b0 - Bb[s * GS + d]);
      if (s == 0) { DEC[((size_t)(0 * NCHUNK + n) * 4 + h) * 64 + d] = __expf(bl); DEC[((size_t)(1 * NCHUNK + n) * 4 + h) * 64 + d] = __expf(b0); } }
    v4u w;
    w.x = pk2(kef[0], kef[1]); w.y = pk2(kef[2], kef[3]); w.z = pk2(kef[4], kef[5]); w.w = pk2(kef[6], kef[7]); *(LAS v4u*)(lds + L_KTF + (s * ST72 + dg * 8) * 2) = w;
    w.x = pk2(keb[0], keb[1]); w.y = pk2(keb[2], keb[3]); w.z = pk2(keb[4], keb[5]); w.w = pk2(keb[6], keb[7]); *(LAS v4u*)(lds + L_KTB + (s * ST72 + dg * 8) * 2) = w; }
  LBAR();
  const int dt = wid >> 2, et = wid & 3, r32 = lane & 31, hi = lane >> 5;
#pragma unroll
  for (int dir = 0; dir < 2; ++dir) { f32x16 acc = {};
#pragma unroll
    for (int ks = 0; ks < 4; ++ks) acc = __builtin_amdgcn_mfma_f32_32x32x16_bf16(trfrag(lds + (dir ? L_KTB : L_KTF), ST72 * 2, 16 * ks, 32 * dt, lane), trfrag(lds + L_V, VS, 16 * ks, 32 * et, lane), acc, 0, 0, 0);
    bf16* So = STATE + ((size_t)(dir * NCHUNK + n) * 4 + h) * 8192;
#pragma unroll
    for (int r = 0; r < 16; ++r) So[(32 * dt + crow(r, hi)) * 128 + 32 * et + r32] = (bf16)f2bf(acc[r]); }
  LBAR();
}
__device__ __forceinline__ void g3_unit(const GPre& R, const float* __restrict__ gng, bf16* __restrict__ MIXIN, int n, int h, LAS char* lds) {
  int tid_ = threadIdx.x; asm volatile("" : "+v"(tid_)); const int tid = tid_, lane = tid & 63, wid = __builtin_amdgcn_readfirstlane(tid >> 6), s = tid >> 3, dg = tid & 7, row0 = n * 64, r32 = lane & 31, hi = lane >> 5;
  const v4u kk = R.kk, qq = R.qq;
  prep<true>(R, n, h, lds);
  { const LAS float* Bf = (const LAS float*)(lds + L_BD); const LAS float* Bb = Bf + 64 * GS;
    float qf[8], kf[8], qb[8], kb[8];
#pragma unroll
    for (int j = 0; j < 8; ++j) { const int d = dg * 8 + j; const float kv = (j & 1) ? bfhi(kk[j >> 1]) : bflo(kk[j >> 1]); const float qv = ((j & 1) ? bfhi(qq[j >> 1]) : bflo(qq[j >> 1])) * 0.125f;
      const float bf_ = Bf[s * GS + d], bb_ = Bb[s * GS + d];
      qf[j] = qv * __expf(bf_); kf[j] = kv * __expf(-bf_); qb[j] = qv * __expf(bb_); kb[j] = kv * __expf(-bb_); }
    v4u w;
    w.x = pk2(qf[0], qf[1]); w.y = pk2(qf[2], qf[3]); w.z = pk2(qf[4], qf[5]); w.w = pk2(qf[6], qf[7]); *(LAS v4u*)(lds + L_QTF + (s * ST72 + dg * 8) * 2) = w;
    w.x = pk2(qb[0], qb[1]); w.y = pk2(qb[2], qb[3]); w.z = pk2(qb[4], qb[5]); w.w = pk2(qb[6], qb[7]); *(LAS v4u*)(lds + L_QTB + (s * ST72 + dg * 8) * 2) = w;
    w.x = pk2(kf[0], kf[1]); w.y = pk2(kf[2], kf[3]); w.z = pk2(kf[4], kf[5]); w.w = pk2(kf[6], kf[7]); *(LAS v4u*)(lds + L_KTF + (s * ST72 + dg * 8) * 2) = w;
    w.x = pk2(kb[0], kb[1]); w.y = pk2(kb[2], kb[3]); w.z = pk2(kb[4], kb[5]); w.w = pk2(kb[6], kb[7]); *(LAS v4u*)(lds + L_KTB + (s * ST72 + dg * 8) * 2) = w; }
  LBAR();
  { const int dir = wid >> 2, ct = (wid >> 1) & 1, st = wid & 1; f32x16 acc = {};
    lcp Q = lds + (dir ? L_QTB : L_QTF); lcp K = lds + (dir ? L_KTB : L_KTF);
#pragma unroll
    for (int ks = 0; ks < 4; ++ks) acc = __builtin_amdgcn_mfma_f32_32x32x16_bf16(frag(Q, 32 * ct, 16 * ks, lane), frag(K, 32 * st, 16 * ks, lane), acc, 0, 0, 0);
    LAS bf16* ATT = (LAS bf16*)(lds + (dir ? L_ATTB : L_ATTF));
#pragma unroll
    for (int r = 0; r < 16; ++r) { const int c = 32 * ct + crow(r, hi), s_ = 32 * st + r32; const bool keep = dir ? (s_ > c) : (s_ <= c);
      ATT[c * ST72 + s_] = (bf16)f2bf(keep ? acc[r] : 0.f); } }
  LBAR();
  { const int ct = wid >> 2, et = wid & 3; f32x16 acc = {};
#pragma unroll
    for (int dir = 0; dir < 2; ++dir) { lcp ATT = lds + (dir ? L_ATTB : L_ATTF); lcp Q = lds + (dir ? L_QTB : L_QTF); lcp S = lds + (dir ? L_SB : L_SF);
#pragma unroll
      for (int ks = 0; ks < 4; ++ks) { acc = __builtin_amdgcn_mfma_f32_32x32x16_bf16(frag(ATT, 32 * ct, 16 * ks, lane), trfrag(lds + L_V, VS, 16 * ks, 32 * et, lane), acc, 0, 0, 0);
                                       acc = __builtin_amdgcn_mfma_f32_32x32x16_bf16(frag(Q, 32 * ct, 16 * ks, lane), trfrag(S, VS, 16 * ks, 32 * et, lane), acc, 0, 0, 0); } }
    LAS float* RS = (LAS float*)(lds + L_RS);
    float ssr[16];
#pragma unroll
    for (int r = 0; r < 16; ++r) { float ss = acc[r] * acc[r]; ss += __shfl_xor(ss, 1); ss += __shfl_xor(ss, 2); ss += __shfl_xor(ss, 4); ss += __shfl_xor(ss, 8); ss += __shfl_xor(ss, 16); ssr[r] = ss; }
    if (r32 == 0) {
#pragma unroll
      for (int r = 0; r < 16; ++r) RS[wid * 32 + crow(r, hi)] = ssr[r]; }
    LBAR();
    const int e = 32 * et + r32; const float g = gng[e];
#pragma unroll
    for (int r = 0; r < 16; ++r) { const int cl = crow(r, hi), c = 32 * ct + cl;
      const float tot = RS[(ct * 4 + 0) * 32 + cl] + RS[(ct * 4 + 1) * 32 + cl] + RS[(ct * 4 + 2) * 32 + cl] + RS[(ct * 4 + 3) * 32 + cl];
      const float sc_ = 1.0f / sqrtf(tot * (1.0f / 128.0f) + EPS);
      const float gr = bf2f(R.grv[r]);
      const float sl = gr * __builtin_amdgcn_rcpf(1.0f + __expf(-gr));
      MIXIN[(size_t)(row0 + c) * DM + 512 + h * 128 + e] = (bf16)f2bf(acc[r] * sc_ * g * sl); }
  }
  LBAR();
}
}

#define XB_TMO      128
#define XB_XCNT(j)  (256  + 64 * (j))
#define XB_XSUB(j)  (1280 + 64 * (j))
#define XB_XGEN(j)  (2304 + 64 * (j))
#define XB_TOP      3328
#define XB_TOPGEN   3392
#define XCD_BAR_WORDS 3456
#define XB_SPIN_CAP (1u << 18)

__device__ __forceinline__ unsigned xb_ld(unsigned* p)              { return __hip_atomic_load(p, __ATOMIC_RELAXED, __HIP_MEMORY_SCOPE_AGENT); }
__device__ __forceinline__ unsigned xb_add(unsigned* p, unsigned v) { return __hip_atomic_fetch_add(p, v, __ATOMIC_RELAXED, __HIP_MEMORY_SCOPE_AGENT); }
__device__ __forceinline__ unsigned xb_xcc_id() { return (unsigned)__builtin_amdgcn_s_getreg((3 << 11) | 20) & 0xFu; }
#define XB_SPIN(cond, bar) do { unsigned _sp = 0; while (cond) { __builtin_amdgcn_s_sleep(1); \
    if ((++_sp & 255u) == 0u) { if (xb_ld(&(bar)[XB_TMO])) break; if (_sp > XB_SPIN_CAP) { atomicAdd(&(bar)[XB_TMO], 1u); break; } } } } while (0)

struct XcdBarrier {
    unsigned* bar; unsigned x;
    volatile LAS unsigned* st;
};

__device__ __forceinline__ XcdBarrier xcd_barrier_post(unsigned* bar, volatile LAS unsigned* st) {
    XcdBarrier b; b.bar = bar; b.x = xb_xcc_id(); b.st = st;
    if (threadIdx.x == 0) (void)xb_add(&bar[XB_XCNT(b.x)], 1u);
    return b;
}
__device__ __forceinline__ void xcd_barrier_complete(unsigned* bar, unsigned x, unsigned& nloc, unsigned& nx) {
    const unsigned G = gridDim.x * gridDim.y * gridDim.z;
    unsigned sum, cnt, mine, sp = 0u;
    for (;;) {
        sum = 0u; cnt = 0u; mine = 0u;
#pragma unroll
        for (unsigned j = 0; j < 16; ++j) { const unsigned c = xb_ld(&bar[XB_XCNT(j)]); sum += c; cnt += (c > 0u) ? 1u : 0u; mine = (j == x) ? c : mine; }
        if (sum == G) break;
        __builtin_amdgcn_s_sleep(1);
        if ((++sp & 255u) == 0u) { if (xb_ld(&bar[XB_TMO])) break; if (sp > XB_SPIN_CAP) { atomicAdd(&bar[XB_TMO], 1u); break; } }
    }
    nloc = mine > 0u ? mine : 1u; nx = cnt > 0u ? cnt : 1u;
}

__device__ __forceinline__ void xcd_barrier(const XcdBarrier& b) {
    asm volatile("s_waitcnt vmcnt(0)" ::: "memory");
    __syncthreads();
    if (threadIdx.x == 0) {
        unsigned* bar = b.bar;
        __builtin_amdgcn_s_waitcnt(0);
        unsigned nloc = b.st[0], nx = b.st[1];
        if (nloc == 0u) { xcd_barrier_complete(bar, b.x, nloc, nx); b.st[0] = nloc; b.st[1] = nx; }
        const unsigned old = xb_add(&bar[XB_XSUB(b.x)], 1u);
        const unsigned gen = old / nloc;
        if (old + 1u == (gen + 1u) * nloc) {
            __builtin_amdgcn_fence(__ATOMIC_RELEASE, "agent");
            asm volatile("s_waitcnt vmcnt(0)" ::: "memory");
            const unsigned og = xb_add(&bar[XB_TOP], 1u);
            const unsigned tg = og / nx;
            if (og + 1u == (tg + 1u) * nx) xb_add(&bar[XB_TOPGEN], 1u);
            else XB_SPIN(xb_ld(&bar[XB_TOPGEN]) == tg, bar);
            __builtin_amdgcn_fence(__ATOMIC_ACQUIRE, "agent");
            xb_add(&bar[XB_XGEN(b.x)], 1u);
            asm volatile("s_waitcnt vmcnt(0)" ::: "memory");
        } else {
            XB_SPIN(xb_ld(&bar[XB_XGEN(b.x)]) == gen, bar);
            __builtin_amdgcn_fence(__ATOMIC_ACQUIRE, "agent");
            asm volatile("s_waitcnt vmcnt(0)" ::: "memory");
        }
    }
    __syncthreads();
}

__global__ void __launch_bounds__(NWAVES * 64, 2) hymba_fwd(Args args) {
    extern __shared__ __attribute__((aligned(16))) unsigned char lds[];
    cg::grid_group grid = cg::this_grid();
    LAS unsigned char* ldsl = (LAS unsigned char*)lds;
    volatile LAS unsigned* MISC = (volatile LAS unsigned*)(ldsl + MISC_OFF);
    const int tid = threadIdx.x, lane = tid & 63, wave = __builtin_amdgcn_readfirstlane(tid >> 6);
    const int G = gridDim.x, bid = blockIdx.x;
    const int gw = bid * NWAVES + wave, NGW = G * NWAVES;
    unsigned char* ws = args.ws;
    unsigned* ctl = (unsigned*)(ws + WS_CTL);
    bf16* Wup_t = (bf16*)(ws + WS_WUP); bf16* Wdown_t = (bf16*)(ws + WS_WDOWN); bf16* Win_t = (bf16*)(ws + WS_WIN); bf16* Wout_t = (bf16*)(ws + WS_WOUT);
    bf16* Wgate_t = (bf16*)(ws + WS_WGATE); bf16* Wproj_t = (bf16*)(ws + WS_WPROJ);
    bf16* H = (bf16*)(ws + WS_H); bf16* PROJ = (bf16*)(ws + WS_PROJ); bf16* MIX = (bf16*)(ws + WS_MIX); bf16* ACT = (bf16*)(ws + WS_ACT);
    bf16* X2B = (bf16*)(ws + WS_X2B); bf16* PB = (bf16*)(ws + WS_PB); bf16* GOUT = (bf16*)(ws + WS_GOUT); bf16* EOUT = (bf16*)(ws + WS_EOUT);
    float* DEC = (float*)(ws + WS_DEC); bf16* STATE = (bf16*)args.out;
    bf16* WGT = (bf16*)(ws + WS_WGT);
    float* OUT = args.out; bf16* X1B = (bf16*)args.out;
    if (tid < 32) MISC[tid] = 0u;
    __syncthreads();
    XcdBarrier xbar = xcd_barrier_post(ctl + CW_BAR, MISC + 8);
    if (gridDim.x > 65535u) grid.sync();

    {
        LAS float* scr = (LAS float*)(ldsl + wave * 16384);
        constexpr int I_IN = 16 * 97, I_OUT = 16 * 32, I_UP = 16 * 256, I_DOWN = 64 * 32, NITEMS = I_IN + I_OUT + I_UP + I_DOWN;
        for (int it = gw; it < NITEMS; it += NGW) {
            int r = it;
            if (r < I_IN) { const int kb = r / 97, nb = r % 97; transpose_item(args.in[5], 1024, 3104, Win_t, 64 * kb, 32 * nb, 32 * nb, scr, lane); continue; } r -= I_IN;
            if (r < I_OUT) { const int kb = r / 32, nb = r % 32; transpose_item(args.in[16], 1024, 1024, Wout_t, 64 * kb, 32 * nb, 32 * nb, scr, lane); continue; } r -= I_OUT;
            if (r < I_UP) { const int kb = r / 256, nb = r % 256; const int n0d = 32 * nb, pn = n0d >> 8, j = n0d & 255; const int n0s = (j < 128) ? (128 * pn + j) : (4096 + 128 * pn + (j - 128));
                transpose_item(args.in[19], 1024, 8192, Wup_t, 64 * kb, n0s, n0d, scr, lane); continue; } r -= I_UP;
            { const int kb = r / 32, nb = r % 32; transpose_item(args.in[22], 4096, 1024, Wdown_t, 64 * kb, 32 * nb, 32 * nb, scr, lane); }
        }
        { v4u z = {0u, 0u, 0u, 0u}; v4u* zp = (v4u*)(Win_t + (size_t)3104 * 1024); const int nz = 224 * 1024 * 2 / 16;
          for (int i = bid * 512 + tid; i < nz; i += G * 512) zp[i] = z; }
        { f32x4 gv[4];
#pragma unroll
          for (int j = 0; j < 4; ++j) gv[j] = *(const f32x4*)(args.in[4] + 4 * lane + 256 * j);
          for (int m = gw; m < MROWS; m += NGW) { const f32x4* xr = (const f32x4*)xrow_ptr(args, m) + lane; f32x4 v[4]; float s = 0.f;
#pragma unroll
            for (int j = 0; j < 4; ++j) { v[j] = __builtin_nontemporal_load(xr + 64 * j); s += (v[j].x * v[j].x + v[j].y * v[j].y) + (v[j].z * v[j].z + v[j].w * v[j].w); }
            const float rs = 1.0f / sqrtf(wave_sum(s) * (1.0f / DM) + EPS);
            v2u* o8 = (v2u*)(H + (size_t)m * DM) + lane;
#pragma unroll
            for (int j = 0; j < 4; ++j) { v2u w; w.x = pk2(v[j].x * rs * gv[j].x, v[j].y * rs * gv[j].y); w.y = pk2(v[j].z * rs * gv[j].z, v[j].w * rs * gv[j].w); o8[64 * j] = w; } } }
        for (int i = bid * 512 + tid; i < 8192; i += G * 512) { const int dir = i >> 12, c = (i >> 4) & 255, r = i & 15; WGT[i] = (bf16)f2bf((dir ? args.in[13] : args.in[11])[r * 256 + c]); }
        if (bid == 0 && wave == 0) { const float a1 = args.in[6][lane] * args.in[7][lane], a2 = args.in[8][lane] * args.in[9][lane];
            const float s1 = wave_sum(a1), s2 = wave_sum(a2); if (lane == 0) ((float*)ctl)[CW_LAM] = __expf(s1) - __expf(s2) + 0.2f; }
    }
    xcd_barrier(xbar);
    { pg8::Gemm g{H, Win_t, MROWS, LDP, 1024}; pg8::StaticOrder S; S.init(MROWS, LDP, G, bid); pg8::EpiBf16S E{PROJ, LDP, 2, 0.125f * 1.4426950408889634f};
      pg8::gemm_phase<pg8::EpiBf16S, pg8::StaticOrder, true, true>(ldsl, g, S, E); }
    xcd_barrier(xbar);
    {
      const int rpw = (MROWS + NGW - 1) / NGW; int m0 = gw * rpw, m1 = m0 + rpw; if (m1 > MROWS) m1 = MROWS;
      float mx = 0.f; int cs = -1;
      for (int m = m0; m < m1; ++m) { const int sq = m < NPROMPT ? (m >> 11) : 16;
        if (sq != cs) { if (cs >= 0 && (lane & 7) == 0) atomicMax(ctl + CW_NORM + cs * 16 + 8 + (lane >> 3), __float_as_uint(mx)); mx = 0.f; cs = sq; }
        const v4u a0 = *(const v4u*)(PROJ + (size_t)m * LDP + C_DAK + lane * 8);
        float ss = 0.f;
#pragma unroll
        for (int i = 0; i < 4; ++i) { const float x0 = bflo(a0[i]), x1 = bfhi(a0[i]); ss += x0 * x0 + x1 * x1; }
        ss += __shfl_xor(ss, 1); ss += __shfl_xor(ss, 2); ss += __shfl_xor(ss, 4); mx = fmaxf(mx, ss); }
      if (cs >= 0 && (lane & 7) == 0) atomicMax(ctl + CW_NORM + cs * 16 + 8 + (lane >> 3), __float_as_uint(mx)); }
    { gla::GPre cur, nxt; int u = bid;
      if (u < NCHUNK * 4) gla::load_pre<false>(cur, PROJ, args, WGT, STATE, u >> 2, u & 3);
      for (; u < NCHUNK * 4; u += G) { const int un = u + G;
        if (un < NCHUNK * 4) gla::load_pre<false>(nxt, PROJ, args, WGT, STATE, un >> 2, un & 3);
        gla::g1_unit(cur, STATE, DEC, u >> 2, u & 3, (LAS char*)ldsl); cur = nxt; } }
    xcd_barrier(xbar);
    {
        constexpr int NI = 2 * 68 * 32;
        for (int i = gw; i < NI; i += NGW) {
            const int sub = i & 31, t = i >> 5, dir = t & 1, sh = t >> 1;
            int n0, nc, h;
            if (sh < 4) { n0 = 512; nc = 256; h = sh; } else { const int v = sh - 4; n0 = 32 * (v >> 2); nc = 32; h = v & 3; }
            const size_t eoff = (size_t)sub * 256 + lane * 4; const int d = sub * 2 + (lane >> 5);
            f32x4 st = {0.f, 0.f, 0.f, 0.f};
            for (int k = 0; k < nc; k += 8) {
                v2u kv[8]; float dc[8];
#pragma unroll
                for (int q = 0; q < 8; ++q) { const int n = dir ? (n0 + nc - 1 - (k + q)) : (n0 + k + q); const size_t ch = (size_t)(dir * NCHUNK + n) * 4 + h;
                    kv[q] = *(const v2u*)(STATE + ch * 8192 + eoff); dc[q] = DEC[ch * 64 + d]; }
#pragma unroll
                for (int q = 0; q < 8; ++q) { const int n = dir ? (n0 + nc - 1 - (k + q)) : (n0 + k + q); const size_t ch = (size_t)(dir * NCHUNK + n) * 4 + h;
                    v2u w; w.x = pk2(st.x, st.y); w.y = pk2(st.z, st.w); *(v2u*)(STATE + ch * 8192 + eoff) = w;
                    const f32x4 kvf = {bflo(kv[q].x), bfhi(kv[q].x), bflo(kv[q].y), bfhi(kv[q].y)}; st = st * dc[q] + kvf; }
            }
        }
        __syncthreads();
        const float lam = ((const float*)ctl)[CW_LAM];
        constexpr int NU = 512 + 1024;
        for (;;) {
            if (tid == 0) MISC[0] = atomicAdd(ctl + CW_QCTR, 1u);
            __syncthreads();
            const int u = (int)MISC[0];
            __syncthreads();
            if (u >= NU) break;
            int seq0, h, q0, nt, sq;
            if (u < 512) { h = 3 - (u >> 7); q0 = (u & 127) * 128; seq0 = NPROMPT; nt = SS / 64; sq = 16; }
            else { const int v = u - 512; h = 3 - (v >> 8); sq = (v >> 4) & 15; q0 = (v & 15) * 128; seq0 = sq * SP; nt = SP / 64; }
            const float slope = (h == 0) ? 0.25f : (h == 1) ? 0.0625f : (h == 2) ? 0.015625f : 0.00390625f;
            const float kmax0 = sqrtf(__uint_as_float(__hip_atomic_load(ctl + CW_NORM + sq * 16 + 8 + h * 2 + 0, __ATOMIC_RELAXED, __HIP_MEMORY_SCOPE_AGENT)));
            const float kmax1 = sqrtf(__uint_as_float(__hip_atomic_load(ctl + CW_NORM + sq * 16 + 8 + h * 2 + 1, __ATOMIC_RELAXED, __HIP_MEMORY_SCOPE_AGENT)));
            da::attn_unit(PROJ, H, args.in[10], seq0, h, q0, nt, kmax0, kmax1, slope, lam, (char*)lds);
        }
    }
    xcd_barrier(xbar);
    { gla::GPre cur, nxt; int u = bid;
      if (u < NCHUNK * 4) gla::load_pre<true>(cur, PROJ, args, WGT, STATE, u >> 2, u & 3);
      for (; u < NCHUNK * 4; u += G) { const int un = u + G;
        if (un < NCHUNK * 4) gla::load_pre<true>(nxt, PROJ, args, WGT, STATE, un >> 2, un & 3);
        gla::g3_unit(cur, args.in[15], H, u >> 2, u & 3, (LAS char*)ldsl); cur = nxt; } }
    xcd_barrier(xbar);
    { pg8::Gemm g{H, Wout_t, MROWS, 1024, 1024}; pg8::StaticOrder S; S.init(MROWS, 1024, G, bid); pg8::EpiBf16S E{MIX, 1024, 0, 1.f};
      pg8::gemm_phase<pg8::EpiBf16S, pg8::StaticOrder, true, true>(ldsl, g, S, E); }
    xcd_barrier(xbar);
    {
      int tidf_ = threadIdx.x; asm volatile("" : "+v"(tidf_)); const int tid = tidf_, lane = tid & 63, wave = __builtin_amdgcn_readfirstlane(tid >> 6), gw = bid * NWAVES + wave; (void)tid; (void)wave;
      f32x4 g1[4], g2[4];
#pragma unroll
      for (int j = 0; j < 4; ++j) { g1[j] = *(const f32x4*)(args.in[17] + 4 * lane + 256 * j); g2[j] = *(const f32x4*)(args.in[18] + 4 * lane + 256 * j); }
      for (int m = gw; m < MROWS; m += NGW) { const f32x4* xr = (const f32x4*)xrow_ptr(args, m) + lane; const v2u* mr = (const v2u*)(MIX + (size_t)m * DM) + lane;
        f32x4 v[4], mx[4]; float s = 0.f;
#pragma unroll
        for (int j = 0; j < 4; ++j) { v[j] = __builtin_nontemporal_load(xr + 64 * j); const v2u w = __builtin_nontemporal_load(mr + 64 * j); mx[j] = (f32x4){bflo(w.x), bfhi(w.x), bflo(w.y), bfhi(w.y)};
          s += (mx[j].x * mx[j].x + mx[j].y * mx[j].y) + (mx[j].z * mx[j].z + mx[j].w * mx[j].w); }
        const float rs = 1.0f / sqrtf(wave_sum(s) * (1.0f / DM) + EPS); float s2 = 0.f;
        v2u* orow = (v2u*)(X1B + (size_t)m * DM) + lane;
#pragma unroll
        for (int j = 0; j < 4; ++j) { v[j] = v[j] + mx[j] * rs * g1[j]; { v2u w; w.x = pk2(v[j].x, v[j].y); w.y = pk2(v[j].z, v[j].w); __builtin_nontemporal_store(w, orow + 64 * j); } s2 += (v[j].x * v[j].x + v[j].y * v[j].y) + (v[j].z * v[j].z + v[j].w * v[j].w); }
        const float rs2 = 1.0f / sqrtf(wave_sum(s2) * (1.0f / DM) + EPS);
        v2u* o8 = (v2u*)(H + (size_t)m * DM) + lane;
        const int sm = m & 127; int crowi = -1;
        if (sm >= 126) crowi = 4 * (((m >> 7) + 1) % NGRP) + (sm - 126); else if (sm <= 1) crowi = 4 * (m >> 7) + 2 + sm;
        v2u* c8 = (v2u*)(H + (size_t)(MROWS + (crowi < 0 ? 0 : crowi)) * DM) + lane;
#pragma unroll
        for (int j = 0; j < 4; ++j) { v2u w; w.x = pk2(v[j].x * rs2 * g2[j].x, v[j].y * rs2 * g2[j].y); w.y = pk2(v[j].z * rs2 * g2[j].z, v[j].w * rs2 * g2[j].w); o8[64 * j] = w; if (crowi >= 0) c8[64 * j] = w; } } }
    xcd_barrier(xbar);
    { pg8::Gemm g{H, Wup_t, MROWS + NFIXROWS, 8192, 1024}; pg8::StaticOrder S; S.init(MROWS + NFIXROWS, 8192, G, bid); pg8::EpiConvGelu E{ACT, args.in[20], args.in[21], NMAINT, MROWS};
      pg8::gemm_phase<pg8::EpiConvGelu, pg8::StaticOrder, true, true, true>(ldsl, g, S, E); }
    xcd_barrier(xbar);
    { pg8::Gemm g{ACT, Wdown_t, MROWS, 1024, 4096}; pg8::StaticOrder S; S.init(MROWS, 1024, G, bid); pg8::EpiBf16S E{H, 1024, 0, 1.f};
      pg8::gemm_phase<pg8::EpiBf16S, pg8::StaticOrder, true, true>(ldsl, g, S, E); }
    xcd_barrier(xbar);
    {
      int tidf_ = threadIdx.x; asm volatile("" : "+v"(tidf_)); const int tid = tidf_, lane = tid & 63, wave = __builtin_amdgcn_readfirstlane(tid >> 6), gw = bid * NWAVES + wave; (void)tid; (void)wave;
        LAS float* scr = (LAS float*)(ldsl + wave * 16384);
        constexpr int I_G = 16 * 32, I_P = 4 * 32;
        for (int it = gw; it < I_G + I_P; it += NGW) {
            if (it < I_G) { const int kb = it / 32, nb = it % 32; transpose_item(args.in[24], 1024, 1024, Wgate_t, 64 * kb, 32 * nb, 32 * nb, scr, lane); }
            else { const int r = it - I_G; const int kb = r / 32, nb = r % 32; transpose_item(args.in[26], 256, 1024, Wproj_t, 64 * kb, 32 * nb, 32 * nb, scr, lane); }
        }
        f32x4 g1[4];
#pragma unroll
        for (int j = 0; j < 4; ++j) g1[j] = *(const f32x4*)(args.in[23] + 4 * lane + 256 * j);
        for (int m = gw; m < MROWS; m += NGW) { const v2u* xr = (const v2u*)(X1B + (size_t)m * DM) + lane; const v2u* mr = (const v2u*)(H + (size_t)m * DM) + lane;
            f32x4 v[4], mx[4]; float s = 0.f;
#pragma unroll
            for (int j = 0; j < 4; ++j) { { const v2u wx = __builtin_nontemporal_load(xr + 64 * j); v[j] = (f32x4){bflo(wx.x), bfhi(wx.x), bflo(wx.y), bfhi(wx.y)}; } const v2u w = __builtin_nontemporal_load(mr + 64 * j); mx[j] = (f32x4){bflo(w.x), bfhi(w.x), bflo(w.y), bfhi(w.y)};
              s += (mx[j].x * mx[j].x + mx[j].y * mx[j].y) + (mx[j].z * mx[j].z + mx[j].w * mx[j].w); }
            const float rs = 1.0f / sqrtf(wave_sum(s) * (1.0f / DM) + EPS);
            v2u* o8 = (v2u*)(X2B + (size_t)m * DM) + lane;
#pragma unroll
            for (int j = 0; j < 4; ++j) { v[j] = v[j] + mx[j] * rs * g1[j]; v2u w; w.x = pk2(v[j].x, v[j].y); w.y = pk2(v[j].z, v[j].w); o8[64 * j] = w; }
            const f32x4 pv = __builtin_nontemporal_load((const f32x4*)prow_ptr(args, m) + lane); v2u w; w.x = pk2(pv.x, pv.y); w.y = pk2(pv.z, pv.w); *((v2u*)(PB + (size_t)m * 256) + lane) = w; }
    }
    xcd_barrier(xbar);
    { pg8::Gemm g{X2B, Wgate_t, MROWS, 1024, 1024}; pg8::StaticOrder S; S.init(MROWS, 1024, G, bid); pg8::EpiBf16S E{GOUT, 1024, 0, 1.f};
      pg8::gemm_phase<pg8::EpiBf16S, pg8::StaticOrder, true, true>(ldsl, g, S, E); }
    __syncthreads();
    { pg8::Gemm g{PB, Wproj_t, MROWS, 1024, 256}; pg8::StaticOrder S; S.init(MROWS, 1024, G, bid); pg8::EpiBf16S E{EOUT, 1024, 0, 1.f};
      pg8::gemm_phase<pg8::EpiBf16S, pg8::StaticOrder, true, true>(ldsl, g, S, E); }
    xcd_barrier(xbar);
    {
      int tidf_ = threadIdx.x; asm volatile("" : "+v"(tidf_)); const int tid = tidf_, lane = tid & 63, wave = __builtin_amdgcn_readfirstlane(tid >> 6), gw = bid * NWAVES + wave; (void)tid; (void)wave;
      f32x4 ge[4], bg[4];
#pragma unroll
      for (int j = 0; j < 4; ++j) { ge[j] = *(const f32x4*)(args.in[27] + 4 * lane + 256 * j); bg[j] = *(const f32x4*)(args.in[25] + 4 * lane + 256 * j); }
      for (int m = gw; m < MROWS; m += NGW) { f32x4* xr = (f32x4*)(OUT + (size_t)m * DM) + lane; const v2u* x2r = (const v2u*)(X2B + (size_t)m * DM) + lane; const v2u* er = (const v2u*)(EOUT + (size_t)m * DM) + lane; const v2u* gr = (const v2u*)(GOUT + (size_t)m * DM) + lane;
        f32x4 v[4], ex[4], gx[4]; float s = 0.f;
#pragma unroll
        for (int j = 0; j < 4; ++j) { { const v2u wx = __builtin_nontemporal_load(x2r + 64 * j); v[j] = (f32x4){bflo(wx.x), bfhi(wx.x), bflo(wx.y), bfhi(wx.y)}; } const v2u w = __builtin_nontemporal_load(er + 64 * j); ex[j] = (f32x4){bflo(w.x), bfhi(w.x), bflo(w.y), bfhi(w.y)}; const v2u w2 = __builtin_nontemporal_load(gr + 64 * j); gx[j] = (f32x4){bflo(w2.x), bfhi(w2.x), bflo(w2.y), bfhi(w2.y)};
          s += (ex[j].x * ex[j].x + ex[j].y * ex[j].y) + (ex[j].z * ex[j].z + ex[j].w * ex[j].w); }
        const float rs = 1.0f / sqrtf(wave_sum(s) * (1.0f / DM) + EPS);
#pragma unroll
        for (int j = 0; j < 4; ++j) { f32x4 sg;
#pragma unroll
          for (int q = 0; q < 4; ++q) sg[q] = __builtin_amdgcn_rcpf(1.0f + __expf(-(gx[j][q] + bg[j][q])));
          __builtin_nontemporal_store(v[j] + sg * (ex[j] * rs * ge[j]), xr + 64 * j); } } }
}

extern "C" void kernel_launch(void* const* d_in, const int* in_sizes, int n_in, void* d_out, int out_size, void* d_ws, size_t ws_size, hipStream_t stream) {
    static int grid = 0;
    if (grid == 0) {
        if (n_in != 28 || out_size != MROWS * DM || ws_size < WS_END) { fprintf(stderr, "kernel_launch: unexpected shapes: n_in %d out %d ws %zu (need %zu)\n", n_in, out_size, ws_size, (size_t)WS_END); grid = -1; return; }
        int dev = 0, cus = 0, per_cu = 0;
        hipGetDevice(&dev); hipDeviceGetAttribute(&cus, hipDeviceAttributeMultiprocessorCount, dev);
        if (hipFuncSetAttribute((const void*)hymba_fwd, hipFuncAttributeMaxDynamicSharedMemorySize, LDS_BYTES) != hipSuccess) { fprintf(stderr, "kernel_launch: hipFuncSetAttribute failed\n"); grid = -1; return; }
        if (hipOccupancyMaxActiveBlocksPerMultiprocessor(&per_cu, (const void*)hymba_fwd, NWAVES * 64, LDS_BYTES) != hipSuccess || per_cu < 1) { fprintf(stderr, "kernel_launch: occupancy query failed (%d)\n", per_cu); per_cu = 1; }
        (void)hipGetLastError();
        grid = cus * per_cu;
    }
    if (grid < 0) return;
    (void)hipMemsetAsync((char*)d_ws + WS_CTL, 0, CTL_ZERO_BYTES, stream);
    Args a{};
    for (int i = 0; i < 28; ++i) a.in[i] = (const float*)d_in[i];
    a.out = (float*)d_out; a.ws = (unsigned char*)d_ws;
    void* kargs[] = {&a};
    hipError_t e = hipLaunchCooperativeKernel((const void*)hymba_fwd, dim3(grid), dim3(NWAVES * 64), kargs, LDS_BYTES, stream);
    if (e != hipSuccess) fprintf(stderr, "cooperative launch failed: %s (grid %d)\n", hipGetErrorString(e), grid);
}
```

```cpp
#include <hip/hip_runtime.h>
#include <hip/hip_cooperative_groups.h>
#include <cstdio>
#include <cstdint>
namespace cg = cooperative_groups;
namespace pg8 {
#define PG8_LAS __attribute__((address_space(3)))
typedef unsigned short bf16_t;
typedef short bf16x8 __attribute__((ext_vector_type(8)));
typedef float f32x4 __attribute__((ext_vector_type(4)));
typedef unsigned u32x4 __attribute__((ext_vector_type(4)));
constexpr int BM = 256, BK = 64, HALF = 128, HTB = HALF * BK * 2  , STAGE_BYTES = 8 * HTB, NXCD = 8, WGM = 8;

__host__ __device__ __forceinline__ int lds_byte(int r, int c) { const int st = (r >> 4) * 2 + (c >> 5), rr = r & 15, cc = c & 31, ob = rr * 64 + cc * 2; return st * 1024 + (ob ^ (((ob >> 9) & 1) << 5)); }
__host__ __device__ __forceinline__ void stage_rc(int b, int& R, int& C) { const int st = b / 1024, sb = b % 1024, swz = sb ^ (((sb >> 9) & 1) << 5); R = (st >> 1) * 16 + swz / 64; C = (st & 1) * 32 + (swz % 64) / 2; }
__host__ __device__ __forceinline__ int perm32(int rho) { const int n = rho >> 4, i = rho & 15; return 8 * (i >> 2) + 4 * n + (i & 3); }

struct Unit { int pm, pn; };
struct Gemm { const bf16_t* A; const bf16_t* Bt; int M, N, K; };

struct StaticOrder {
    int nM, nN, nwg, G, c;
    __host__ __device__ void init(int M, int N, int G_, int c_) { nM = M / BM; nN = N / BM; nwg = nM * nN; G = G_; c = c_; }
    __host__ __device__ bool next(int i, Unit& u) const {
        const long L = (long)i * G + c; if (L >= nwg) return false;
        int wgid = (int)L; { const int q = nwg / NXCD, r = nwg % NXCD, xcd = wgid % NXCD, off = wgid / NXCD; wgid = (xcd < r ? xcd * (q + 1) : r * (q + 1) + (xcd - r) * q) + off; }
        const int nig = WGM * nN, gid = wgid / nig, fm = gid * WGM, gsz = (nM - fm) < WGM ? (nM - fm) : WGM;
        u.pm = fm + ((wgid % nig) % gsz); u.pn = (wgid % nig) / gsz; return true;
    }
    __device__ __forceinline__ void a_ready(const Unit&) const {}
    __device__ __forceinline__ void done(const Unit&) const {}
};

__device__ __forceinline__ unsigned cvt_pk_bf16(float lo, float hi) { unsigned r; asm volatile("v_cvt_pk_bf16_f32 %0, %1, %2" : "=v"(r) : "v"(lo), "v"(hi)); return r; }
typedef float f32x2 __attribute__((ext_vector_type(2)));
typedef float f32x2 __attribute__((ext_vector_type(2)));
struct EpiBf16S {
    static constexpr bool PERM = true, AFTER_DRAIN = false;
    bf16_t* O; int ldc; int scale_tiles; float scale0;
    __device__ __forceinline__ void operator()(const f32x4 (&acc)[2][2][4][2], const Unit& u, int wr, int wc, int fr, int fq) const {
        const int row0 = u.pm * BM + wr * 64 + fr; const int col0 = u.pn * BM + wc * 32 + 8 * fq; const float sc = (u.pn < scale_tiles) ? scale0 : 1.f;
#pragma unroll
        for (int ai = 0; ai < 2; ++ai)
#pragma unroll
            for (int m = 0; m < 4; ++m) { bf16_t* rowp = O + (size_t)(row0 + ai * HALF + m * 16) * ldc + col0;
#pragma unroll
                for (int bj = 0; bj < 2; ++bj) { const f32x4 v0 = acc[ai][bj][m][0] * sc, v1 = acc[ai][bj][m][1] * sc;
                    u32x4 w; w.x = cvt_pk_bf16(v0[0], v0[1]); w.y = cvt_pk_bf16(v0[2], v0[3]); w.z = cvt_pk_bf16(v1[0], v1[1]); w.w = cvt_pk_bf16(v1[2], v1[3]);
                    __builtin_nontemporal_store(w, (u32x4*)(rowp + bj * HALF)); } }
    }
};
__device__ __forceinline__ float dpp_ror1(float v) { return __builtin_bit_cast(float, __builtin_amdgcn_update_dpp(0, __builtin_bit_cast(int, v), 0x121, 0xf, 0xf, false)); }
__device__ __forceinline__ float dpp_ror15(float v) { return __builtin_bit_cast(float, __builtin_amdgcn_update_dpp(0, __builtin_bit_cast(int, v), 0x12F, 0xf, 0xf, false)); }
__device__ __forceinline__ float gelu_tanh(float v) {
    const float inner = v * fmaf(0.044715f, v * v, 1.0f);
    const float e = __builtin_amdgcn_exp2f(inner * (-2.0f * 0.7978845608028654f * 1.4426950408889634f));
    return v * __builtin_amdgcn_rcpf(1.0f + e);
}
struct EpiConvGelu {
    static constexpr bool PERM = true, AFTER_DRAIN = false;
    bf16_t* ACT; const float* cw; const float* cb; int nmain; int mrows;
    __device__ __forceinline__ void operator()(const f32x4 (&acc)[2][2][4][2], const Unit& u, int wr, int wc, int fr, int fq) const {
        const bool fix = u.pm >= nmain;
        const int ch0 = u.pn * 128 + wc * 32 + 8 * fq;
        f32x4 w0[2], w1[2], w2[2], bb[2];
#pragma unroll
        for (int n = 0; n < 2; ++n) { w0[n] = *(const f32x4*)(cw + ch0 + 4 * n); w1[n] = *(const f32x4*)(cw + 4096 + ch0 + 4 * n); w2[n] = *(const f32x4*)(cw + 8192 + ch0 + 4 * n); bb[n] = *(const f32x4*)(cb + ch0 + 4 * n); }
#pragma unroll
        for (int ai = 0; ai < 2; ++ai)
#pragma unroll
            for (int m = 0; m < 4; ++m) {
                bool valid; int grow; bool zp = false, zn = false;
                if (!fix) { valid = !((ai == 0 && m == 0 && fr == 0) || (ai == 1 && m == 3 && fr == 15)); grow = u.pm * BM + wr * HALF + ai * 64 + m * 16 + fr; }
                else { const int R = (u.pm - nmain) * BM + wr * HALF + ai * 64 + m * 16 + fr; const int grp = R >> 2, pos = R & 3;
                    const bool ss = (grp < 256) ? ((grp & 15) == 0) : (grp == 256);
                    valid = (pos == 1) || (pos == 2); grow = (pos == 1) ? ((grp * 128 - 1 + mrows) % mrows) : (grp * 128);
                    zn = (pos == 1) && ss; zp = (pos == 2) && ss; }
                f32x4 res[2];
                const float fzp = zp ? 0.f : 1.f, fzn = zn ? 0.f : 1.f;
#pragma unroll
                for (int n = 0; n < 2; ++n) {
                    const f32x4 g = acc[ai][0][m][n], up = acc[ai][1][m][n];
                    f32x4 tp = g, tn = g;
                    if (!fix) { const f32x4 gm = (m > 0) ? acc[ai][0][m - 1][n] : acc[ai ^ 1][0][3][n], gx = (m < 3) ? acc[ai][0][m + 1][n] : acc[ai ^ 1][0][0][n];
                        tp = (fr == 15) ? gm : g; tn = (fr == 0) ? gx : g; }
                    f32x4 gp, gn;
#pragma unroll
                    for (int j = 0; j < 4; ++j) { gp[j] = dpp_ror1(tp[j]); gn[j] = dpp_ror15(tn[j]); }
                    const f32x4 cv = (w0[n] * fzp) * gp + (w1[n] * g + ((w2[n] * fzn) * gn + bb[n]));
                    const f32x4 inner = cv * (cv * cv * 0.044715f + 1.0f) * (-2.0f * 0.7978845608028654f * 1.4426950408889634f);
                    f32x4 sg;
#pragma unroll
                    for (int j = 0; j < 4; ++j) sg[j] = __builtin_amdgcn_rcpf(1.0f + __builtin_amdgcn_exp2f(inner[j]));
                    res[n] = cv * sg * up;
                }
                if (valid) { u32x4 w; w.x = cvt_pk_bf16(res[0][0], res[0][1]); w.y = cvt_pk_bf16(res[0][2], res[0][3]); w.z = cvt_pk_bf16(res[1][0], res[1][1]); w.w = cvt_pk_bf16(res[1][2], res[1][3]);
                    __builtin_nontemporal_store(w, (u32x4*)(ACT + (size_t)grow * 4096 + ch0)); }
            }
    }
};
template <class Epi, class Sched, bool ALIGN_EPI = false, bool SP2 = false, bool AROWS128 = false>
__device__ __forceinline__ void gemm_phase(PG8_LAS unsigned char* lds, const Gemm g, const Sched& S, const Epi& E) {
    int tid_ = threadIdx.x; asm volatile("" : "+v"(tid_)); const int tid = tid_, wid = __builtin_amdgcn_readfirstlane(tid >> 6), lane = tid & 63, wr = wid >> 2, wc = wid & 3, fr = lane & 15, fq = lane >> 4;
    const int K = g.K, nt = K / BK;
    unsigned voffA[2], voffB[2];
#pragma unroll
    for (int i = 0; i < 2; ++i) { int R, C; stage_rc(tid * 16 + i * 8192, R, C); const int Rb = Epi::PERM ? ((R & ~31) + perm32(R & 31)) : R;
        const int Ra = AROWS128 ? (128 * (R >> 6) + (R & 63)) : R;
        voffA[i] = (unsigned)(Ra * K + C) * 2u; voffB[i] = (unsigned)(Rb * K + C) * 2u; }
    const size_t kstep = (size_t)(BK * 2);
    const size_t hstep = (size_t)HALF * K * 2;
    const size_t tstep = 2 * hstep;
    const size_t hstepA = AROWS128 ? hstep / 2 : hstep;
    const unsigned ldsw = (unsigned)wid * 1024u;
    const int aoff = lds_byte(wr * 64 + fr, fq * 8), boff = lds_byte(wc * 32 + fr, fq * 8);
#define PG8_SA(b, h) (((b) * 2 + (h)) * HTB)
#define PG8_SB(b, h) ((4 + (b) * 2 + (h)) * HTB)
#define PG8_STAGE(bufoff, gbase, voff) do { _Pragma("unroll") for (int _i = 0; _i < 2; ++_i) \
        __builtin_amdgcn_global_load_lds((const unsigned*)((const char*)(gbase) + (voff)[_i]), (PG8_LAS unsigned*)(lds + (bufoff) + ldsw + _i * 8192), 16, 0, 0); } while (0)
#define PG8_LDA(dst, b, h) do { _Pragma("unroll") for (int m = 0; m < 4; ++m) _Pragma("unroll") for (int k = 0; k < 2; ++k) dst[m][k] = *(const PG8_LAS bf16x8*)(lds + PG8_SA(b, h) + aoff + m * 2048 + k * 1024); } while (0)
#define PG8_LDB(dst, b, h) do { _Pragma("unroll") for (int n = 0; n < 2; ++n) _Pragma("unroll") for (int k = 0; k < 2; ++k) dst[n][k] = *(const PG8_LAS bf16x8*)(lds + PG8_SB(b, h) + boff + n * 2048 + k * 1024); } while (0)
#define PG8_MMA(ai, bj, At, Bt) do { __builtin_amdgcn_s_setprio(1); _Pragma("unroll") for (int m = 0; m < 4; ++m) _Pragma("unroll") for (int n = 0; n < 2; ++n) _Pragma("unroll") for (int k = 0; k < 2; ++k) \
        acc[ai][bj][m][n] = __builtin_amdgcn_mfma_f32_16x16x32_bf16(Bt[n][k], At[m][k], acc[ai][bj][m][n], 0, 0, 0); __builtin_amdgcn_s_setprio(0); } while (0)
#define PG8_WAIT_V(n) asm volatile("s_waitcnt vmcnt(" #n ")" ::: "memory")
#define PG8_WAIT_L(n) asm volatile("s_waitcnt lgkmcnt(" #n ")" ::: "memory")
#define PG8_BAR __builtin_amdgcn_s_barrier()
#define PG8_SCHED __builtin_amdgcn_sched_barrier(0)
    Unit cur, nxt; int ui = 0;
    if (!S.next(0, cur)) return;
    f32x4 acc[2][2][4][2];
#pragma unroll
    for (int a = 0; a < 2; ++a)
#pragma unroll
        for (int b = 0; b < 2; ++b)
#pragma unroll
            for (int m = 0; m < 4; ++m)
#pragma unroll
                for (int n = 0; n < 2; ++n) acc[a][b][m][n] = (f32x4){0.f, 0.f, 0.f, 0.f};
    bf16x8 At[4][2], B0[2][2], B1[2][2];
    const char* cA = (const char*)g.A + (size_t)cur.pm * tstep; const char* cB = (const char*)g.Bt + (size_t)cur.pn * tstep;
    S.a_ready(cur);
    if constexpr (SP2) {
        PG8_STAGE(PG8_SB(0, 0), cB, voffB); PG8_STAGE(PG8_SB(0, 1), cB + hstep, voffB); PG8_STAGE(PG8_SA(0, 0), cA, voffA); PG8_STAGE(PG8_SA(0, 1), cA + hstepA, voffA);
        if (wr == 1) PG8_BAR;
        PG8_WAIT_V(2); PG8_BAR;
        PG8_STAGE(PG8_SB(1, 0), cB + kstep, voffB); PG8_STAGE(PG8_SA(1, 0), cA + kstep, voffA); PG8_STAGE(PG8_SB(1, 1), cB + hstep + kstep, voffB);
        PG8_WAIT_V(6); PG8_BAR;
    } else {
        PG8_STAGE(PG8_SB(0, 0), cB, voffB); PG8_STAGE(PG8_SA(0, 0), cA, voffA); PG8_STAGE(PG8_SB(0, 1), cB + hstep, voffB); PG8_STAGE(PG8_SA(0, 1), cA + hstepA, voffA);
        if (wr == 1) PG8_BAR;
        PG8_WAIT_V(4); PG8_BAR;
        PG8_STAGE(PG8_SB(1, 0), cB + kstep, voffB); PG8_STAGE(PG8_SA(1, 0), cA + kstep, voffA); PG8_STAGE(PG8_SB(1, 1), cB + hstep + kstep, voffB);
        PG8_WAIT_V(6); PG8_BAR;
    }
    for (;;) {
        const bool has_next = S.next(ui + 1, nxt);
        const char* nA = has_next ? (const char*)g.A + (size_t)nxt.pm * tstep : cA; const char* nB = has_next ? (const char*)g.Bt + (size_t)nxt.pn * tstep : cB;
        for (int t = 0; t < nt; t += 2) {
            const bool last = (t == nt - 2);
            const char* a1 = cA + (size_t)(t + 1) * kstep;
            const char* a2 = last ? nA : cA + (size_t)(t + 2) * kstep; const char* b2 = last ? nB : cB + (size_t)(t + 2) * kstep;
            const char* a3 = a2 + kstep; const char* b3 = b2 + kstep;
            if (last && has_next) S.a_ready(nxt);
            if constexpr (SP2) {
            PG8_LDB(B0, 0, 0); PG8_LDB(B1, 0, 1); PG8_SCHED; PG8_LDA(At, 0, 0); PG8_STAGE(PG8_SA(1, 1), a1 + hstepA, voffA);
            PG8_WAIT_V(8); PG8_WAIT_L(0); PG8_BAR; PG8_MMA(0, 0, At, B0); PG8_MMA(0, 1, At, B1); PG8_BAR; PG8_SCHED;
            PG8_LDA(At, 0, 1); PG8_STAGE(PG8_SB(0, 0), b2, voffB); PG8_STAGE(PG8_SB(0, 1), b2 + hstep, voffB); PG8_STAGE(PG8_SA(0, 0), a2, voffA);
            PG8_WAIT_V(8); PG8_WAIT_L(0); PG8_BAR; PG8_MMA(1, 0, At, B0); PG8_MMA(1, 1, At, B1); PG8_BAR; PG8_SCHED;
            PG8_LDB(B0, 1, 0); PG8_LDB(B1, 1, 1); PG8_SCHED; PG8_LDA(At, 1, 0); PG8_STAGE(PG8_SA(0, 1), a2 + hstepA, voffA);
            PG8_WAIT_V(8); PG8_WAIT_L(0); PG8_BAR; PG8_MMA(0, 0, At, B0); PG8_MMA(0, 1, At, B1); PG8_BAR; PG8_SCHED;
            PG8_LDA(At, 1, 1); PG8_STAGE(PG8_SB(1, 0), b3, voffB); PG8_STAGE(PG8_SB(1, 1), b3 + hstep, voffB); PG8_STAGE(PG8_SA(1, 0), a3, voffA);
            PG8_WAIT_V(8); PG8_WAIT_L(0); PG8_BAR; PG8_MMA(1, 0, At, B0); PG8_MMA(1, 1, At, B1); PG8_BAR; PG8_SCHED;
            } else {
            PG8_LDB(B0, 0, 0); PG8_SCHED; PG8_LDA(At, 0, 0); PG8_STAGE(PG8_SA(1, 1), a1 + hstepA, voffA);
            PG8_WAIT_L(8); PG8_BAR; PG8_WAIT_L(0); PG8_MMA(0, 0, At, B0); PG8_BAR; PG8_SCHED;
            PG8_LDB(B1, 0, 1); PG8_STAGE(PG8_SB(0, 0), b2, voffB);
            PG8_BAR; PG8_WAIT_L(0); PG8_MMA(0, 1, At, B1); PG8_BAR;
            PG8_LDA(At, 0, 1); PG8_STAGE(PG8_SA(0, 0), a2, voffA);
            PG8_BAR; PG8_WAIT_L(0); PG8_MMA(1, 0, At, B0); PG8_BAR; PG8_SCHED;
            PG8_STAGE(PG8_SB(0, 1), b2 + hstep, voffB);
            PG8_WAIT_V(6); PG8_BAR; PG8_MMA(1, 1, At, B1); PG8_BAR;
            PG8_LDB(B0, 1, 0); PG8_SCHED; PG8_LDA(At, 1, 0); PG8_STAGE(PG8_SA(0, 1), a2 + hstepA, voffA);
            PG8_WAIT_L(8); PG8_BAR; PG8_WAIT_L(0); PG8_MMA(0, 0, At, B0); PG8_BAR; PG8_SCHED;
            PG8_LDB(B1, 1, 1); PG8_STAGE(PG8_SB(1, 0), b3, voffB);
            PG8_BAR; PG8_WAIT_L(0); PG8_MMA(0, 1, At, B1); PG8_BAR;
            PG8_LDA(At, 1, 1); PG8_STAGE(PG8_SA(1, 0), a3, voffA);
            PG8_BAR; PG8_WAIT_L(0); PG8_MMA(1, 0, At, B0); PG8_BAR; PG8_SCHED;
            PG8_STAGE(PG8_SB(1, 1), b3 + hstep, voffB);
            PG8_WAIT_V(6); PG8_BAR; PG8_MMA(1, 1, At, B1); PG8_BAR;
            }
        }
        if constexpr (ALIGN_EPI) { if (wr == 0) PG8_BAR; }
        if constexpr (!Epi::AFTER_DRAIN) { E(acc, cur, wr, wc, fr, fq); S.done(cur); }
        if (!has_next) break;
#pragma unroll
        for (int a = 0; a < 2; ++a)
#pragma unroll
            for (int b = 0; b < 2; ++b)
#pragma unroll
                for (int m = 0; m < 4; ++m)
#pragma unroll
                    for (int n = 0; n < 2; ++n) acc[a][b][m][n] = (f32x4){0.f, 0.f, 0.f, 0.f};
        cur = nxt; cA = nA; cB = nB; ++ui;
        if constexpr (ALIGN_EPI) { if (wr == 1) PG8_BAR; }
    }
    PG8_WAIT_V(0);
    if constexpr (!ALIGN_EPI) { if (wr == 0) PG8_BAR; }
    PG8_BAR;
    if constexpr (Epi::AFTER_DRAIN) { E.fused(acc, cur, wr, wc, fr, fq, lds, wid, lane); S.done(cur); }
#undef PG8_SA
#undef PG8_SB
#undef PG8_STAGE
#undef PG8_LDA
#undef PG8_LDB
#undef PG8_MMA
#undef PG8_WAIT_V
#undef PG8_WAIT_L
#undef PG8_BAR
#undef PG8_SCHED
}
}

constexpr int DM = 1024, NPROMPT = 32768, NSAMPLE = 16384, MROWS = NPROMPT + NSAMPLE;
constexpr int SP = 2048, SS = 16384;
constexpr int LDP = 3328;
constexpr int C_DAQ = 0, C_DAK = 512, C_DAV = 1024, C_GQ = 1536, C_GK = 1792, C_GV = 2048, C_GR = 2560, C_LRF = 3072, C_LRB = 3088;
constexpr int DFF = 4096, NFIXROWS = 1536, NMAINT = MROWS / 256, NGRP = MROWS / 128;
constexpr float EPS = 1e-6f;
constexpr int NCHUNK = MROWS / 64;
constexpr size_t MiB = 1u << 20;
constexpr size_t WS_CTL = 0, WS_WUP = 1 * MiB, WS_WDOWN = 17 * MiB, WS_H = 25 * MiB, WS_ACT = 127 * MiB, WS_END = 511 * MiB;
constexpr size_t WS_PROJ = WS_ACT, WS_WIN = 439 * MiB, WS_WOUT = 446 * MiB, WS_DEC = 448 * MiB, WS_MIX = WS_ACT;
constexpr size_t WS_X2B = WS_ACT, WS_PB = 223 * MiB, WS_WGATE = 247 * MiB, WS_WPROJ = 249 * MiB, WS_GOUT = 250 * MiB, WS_EOUT = 346 * MiB;
constexpr size_t WS_WGT = 65536;
constexpr int CW_QCTR = 0, CW_LAM = 64, CW_NORM = 128, CW_BAR = 1024;
constexpr int CTL_ZERO_BYTES = 32768;
constexpr int RING_BYTES = 131072, MISC_OFF = RING_BYTES, LDS_BYTES = 147456;
constexpr int NWAVES = 8;

#define LAS __attribute__((address_space(3)))
typedef unsigned short bf16;
typedef unsigned v4u __attribute__((ext_vector_type(4)));
typedef unsigned v2u __attribute__((ext_vector_type(2)));
typedef float f32x4 __attribute__((ext_vector_type(4)));
typedef short bf16x8 __attribute__((ext_vector_type(8)));
typedef short s16x4 __attribute__((ext_vector_type(4)));
typedef float f32x16 __attribute__((ext_vector_type(16)));

__device__ __forceinline__ unsigned f2bf(float f) { unsigned u = __builtin_bit_cast(unsigned, f); return (u + 0x7fffu + ((u >> 16) & 1u)) >> 16; }
__device__ __forceinline__ unsigned pk2(float lo, float hi) { return f2bf(lo) | (f2bf(hi) << 16); }
__device__ __forceinline__ float bf2f(unsigned short b) { return __builtin_bit_cast(float, (unsigned)b << 16); }
__device__ __forceinline__ float bflo(unsigned w) { return __builtin_bit_cast(float, w << 16); }
__device__ __forceinline__ float bfhi(unsigned w) { return __builtin_bit_cast(float, w & 0xffff0000u); }
#define DPPF(v, ctrl, rmask) __builtin_bit_cast(float, __builtin_amdgcn_update_dpp(0, __builtin_bit_cast(int, (float)(v)), ctrl, rmask, 0xf, false))
__device__ __forceinline__ float wave_sum(float v) {
    v += DPPF(v, 0xB1, 0xf); v += DPPF(v, 0x4E, 0xf); v += DPPF(v, 0x141, 0xf); v += DPPF(v, 0x140, 0xf);
    v += DPPF(v, 0x142, 0xa); v += DPPF(v, 0x143, 0xc);
    return __builtin_bit_cast(float, __builtin_amdgcn_readlane(__builtin_bit_cast(int, v), 63));
}
__device__ __forceinline__ int crow(int r, int hi) { return (r & 3) + 8 * (r >> 2) + 4 * hi; }

struct Args {
    const float* in[28]; float* out; unsigned char* ws;
};

__device__ __forceinline__ void transpose_item(const float* W, int K, int N, bf16* WT, int k0, int n0src, int n0dst, LAS float* scr, int lane) {
#pragma unroll 8
    for (int i = 0; i < 32; ++i) { const int kk = 2 * i + (lane >> 5); scr[kk * 33 + (lane & 31)] = __builtin_nontemporal_load(W + (size_t)(k0 + kk) * N + n0src + (lane & 31)); }
    asm volatile("s_waitcnt lgkmcnt(0)" ::: "memory");
    const int c = lane & 7;
#pragma unroll
    for (int j = 0; j < 4; ++j) { const int n = (lane >> 3) + 8 * j; const LAS float* s = scr + (8 * c) * 33 + n;
        v4u o; o.x = pk2(s[0 * 33], s[1 * 33]); o.y = pk2(s[2 * 33], s[3 * 33]); o.z = pk2(s[4 * 33], s[5 * 33]); o.w = pk2(s[6 * 33], s[7 * 33]);
        *(v4u*)(WT + (size_t)(n0dst + n) * K + k0 + 8 * c) = o; }
    asm volatile("s_waitcnt lgkmcnt(0)" ::: "memory");
}
__device__ __forceinline__ const float* xrow_ptr(const Args& a, int row) { return row < NPROMPT ? a.in[0] + (size_t)row * DM : a.in[1] + (size_t)(row - NPROMPT) * DM; }
__device__ __forceinline__ const float* prow_ptr(const Args& a, int row) { return row < NPROMPT ? a.in[2] + (size_t)row * 256 : a.in[3] + (size_t)(row - NPROMPT) * 256; }

namespace da {
constexpr int SHM_V = 16384, SHM_K = 16384;
constexpr float THRL = 0.0f;
#define KSWZ(row, colB) ((row) * 256 + ((colB) ^ (((row) & 7) << 4)))
#define SBAR() __builtin_amdgcn_sched_barrier(0)
__device__ __forceinline__ unsigned cvtpk(float lo, float hi) { unsigned r; asm volatile("v_cvt_pk_bf16_f32 %0, %1, %2" : "=v"(r) : "v"(lo), "v"(hi)); return r; }
#define PK4(P, BASE, OUT) do { unsigned a0 = cvtpk(P[BASE + 0], P[BASE + 1]), a1 = cvtpk(P[BASE + 2], P[BASE + 3]);   \
    unsigned b0 = cvtpk(P[BASE + 4], P[BASE + 5]), b1 = cvtpk(P[BASE + 6], P[BASE + 7]);                              \
    auto r0 = __builtin_amdgcn_permlane32_swap(a0, b0, false, false); auto r1 = __builtin_amdgcn_permlane32_swap(a1, b1, false, false); \
    v4u w = {r0[0], r1[0], r0[1], r1[1]}; OUT = *reinterpret_cast<bf16x8*>(&w); } while (0)
__device__ __forceinline__ void sc_init(f32x16& p0, f32x16& p1, float dq, float nsl2, float m_ref, int side) {
  if (side != 0) { const float sg = (float)side; const float base0 = fmaf(sg * nsl2, dq, -m_ref), base1 = base0 - sg * 32.f * nsl2;
#pragma unroll
    for (int r = 0; r < 16; ++r) { const float c = -sg * nsl2 * (float)((r & 3) + 8 * (r >> 2)); p0[r] = base0 + c; p1[r] = base1 + c; }
  } else {
#pragma unroll
    for (int r = 0; r < 16; ++r) { const float kv = (float)((r & 3) + 8 * (r >> 2)); const float d0 = dq - kv, d1 = d0 - 32.f;
      p0[r] = fmaf(nsl2, __builtin_fabsf(d0), -m_ref); p1[r] = fmaf(nsl2, __builtin_fabsf(d1), -m_ref); }
  }
}
#define KFRAG(d0, which) (*reinterpret_cast<const bf16x8*>(Ks + KSWZ((which) * 32 + r32, (cbase + (d0) * 16 + hi * 8) * 2)))
__device__ __forceinline__ void qk_only(f32x16& p0, f32x16& p1, const char* Ks, const bf16x8* qr, int r32, int hi, int cbase) {
#pragma unroll
  for (int d0 = 0; d0 < 4; ++d0) { const bf16x8 b0 = KFRAG(d0, 0), b1 = KFRAG(d0, 1);
    p0 = __builtin_amdgcn_mfma_f32_32x32x16_bf16(b0, qr[d0], p0, 0, 0, 0); p1 = __builtin_amdgcn_mfma_f32_32x32x16_bf16(b1, qr[d0], p1, 0, 0, 0); }
}
__device__ __forceinline__ void qk_fin(f32x16& n0, f32x16& n1, const char* Ks, const bf16x8* qr, int r32, int hi, int cbase,
                                       const f32x16& q0, const f32x16& q1, float& l_reg, bf16x8& pa0, bf16x8& pa1, bf16x8& pa2, bf16x8& pa3) {
  bf16x8 ka0 = KFRAG(0, 0), ka1 = KFRAG(0, 1), kb0 = KFRAG(1, 0), kb1 = KFRAG(1, 1); float ps = 0.f;
  n0 = __builtin_amdgcn_mfma_f32_32x32x16_bf16(ka0, qr[0], n0, 0, 0, 0); n1 = __builtin_amdgcn_mfma_f32_32x32x16_bf16(ka1, qr[0], n1, 0, 0, 0);
  ka0 = KFRAG(2, 0); ka1 = KFRAG(2, 1);
#pragma unroll
  for (int r = 0; r < 8; ++r) ps += q0[r];
  PK4(q0, 0, pa0); asm volatile("" : "+v"(pa0), "+v"(ps)); SBAR();
  n0 = __builtin_amdgcn_mfma_f32_32x32x16_bf16(kb0, qr[1], n0, 0, 0, 0); n1 = __builtin_amdgcn_mfma_f32_32x32x16_bf16(kb1, qr[1], n1, 0, 0, 0);
  kb0 = KFRAG(3, 0); kb1 = KFRAG(3, 1);
#pragma unroll
  for (int r = 8; r < 16; ++r) ps += q0[r];
  PK4(q0, 8, pa1); asm volatile("" : "+v"(pa1), "+v"(ps)); SBAR();
  n0 = __builtin_amdgcn_mfma_f32_32x32x16_bf16(ka0, qr[2], n0, 0, 0, 0); n1 = __builtin_amdgcn_mfma_f32_32x32x16_bf16(ka1, qr[2], n1, 0, 0, 0);
#pragma unroll
  for (int r = 0; r < 8; ++r) ps += q1[r];
  PK4(q1, 0, pa2); asm volatile("" : "+v"(pa2), "+v"(ps)); SBAR();
  n0 = __builtin_amdgcn_mfma_f32_32x32x16_bf16(kb0, qr[3], n0, 0, 0, 0); n1 = __builtin_amdgcn_mfma_f32_32x32x16_bf16(kb1, qr[3], n1, 0, 0, 0);
#pragma unroll
  for (int r = 8; r < 16; ++r) ps += q1[r];
  PK4(q1, 8, pa3);
  { auto rr = __builtin_amdgcn_permlane32_swap(__float_as_uint(ps), __float_as_uint(ps), false, false); ps = __uint_as_float(rr[0]) + __uint_as_float(rr[1]); }
  l_reg += ps; SBAR();
}
__device__ __forceinline__ void fin_only(const f32x16& q0, const f32x16& q1, float& l_reg, bf16x8& pa0, bf16x8& pa1, bf16x8& pa2, bf16x8& pa3) {
  float ps = 0.f;
#pragma unroll
  for (int r = 0; r < 16; ++r) ps += q0[r];
#pragma unroll
  for (int r = 0; r < 16; ++r) ps += q1[r];
  { auto rr = __builtin_amdgcn_permlane32_swap(__float_as_uint(ps), __float_as_uint(ps), false, false); ps = __uint_as_float(rr[0]) + __uint_as_float(rr[1]); }
  l_reg += ps; PK4(q0, 0, pa0); PK4(q0, 8, pa1); PK4(q1, 0, pa2); PK4(q1, 8, pa3);
}
__device__ __forceinline__ int v_st(int k, int c) { const int kk = (k & ~0xC) | ((k & 4) << 1) | ((k & 8) >> 1); return ((kk >> 3) * 4 + (c >> 5)) * 512 + ((kk & 7) * 32 + (c & 31)) * 2; }
__device__ __forceinline__ int v_rd_base(int lane) { return ((lane & 3) << 3) | (((lane >> 2) & 3) << 6) | (((lane >> 4) & 1) << 5) | (((lane >> 5) & 1) << 8); }
constexpr int v_rd_off(int d0, int ks, int half) { return d0 * 512 + ks * 4096 + half * 2048; }
template <int OFF> __device__ __forceinline__ s16x4 tr_read(int vb) {
  s16x4 r; asm volatile("ds_read_b64_tr_b16 %0, %1 offset:%2" : "=&v"(r) : "v"(vb), "i"(OFF) : "memory"); return r;
}
template <int D0> __device__ __forceinline__ void pv_one(f32x16& od, int vb, bf16x8 pa0, bf16x8 pa1, bf16x8 pa2, bf16x8 pa3) {
  const s16x4 l0 = tr_read<v_rd_off(D0, 0, 0)>(vb), h0 = tr_read<v_rd_off(D0, 0, 1)>(vb), l1 = tr_read<v_rd_off(D0, 1, 0)>(vb), h1 = tr_read<v_rd_off(D0, 1, 1)>(vb);
  const s16x4 l2 = tr_read<v_rd_off(D0, 2, 0)>(vb), h2 = tr_read<v_rd_off(D0, 2, 1)>(vb), l3 = tr_read<v_rd_off(D0, 3, 0)>(vb), h3 = tr_read<v_rd_off(D0, 3, 1)>(vb);
  asm volatile("s_waitcnt lgkmcnt(0)" ::: "memory"); SBAR();
#define PK(L, H) (bf16x8){L[0], L[1], L[2], L[3], H[0], H[1], H[2], H[3]}
  od = __builtin_amdgcn_mfma_f32_32x32x16_bf16(pa0, PK(l0, h0), od, 0, 0, 0);
  od = __builtin_amdgcn_mfma_f32_32x32x16_bf16(pa1, PK(l1, h1), od, 0, 0, 0);
  od = __builtin_amdgcn_mfma_f32_32x32x16_bf16(pa2, PK(l2, h2), od, 0, 0, 0);
  od = __builtin_amdgcn_mfma_f32_32x32x16_bf16(pa3, PK(l3, h3), od, 0, 0, 0);
#undef PK
}
#define RD8(D0, L, H) do { L[0] = tr_read<v_rd_off(D0, 0, 0)>(vb); H[0] = tr_read<v_rd_off(D0, 0, 1)>(vb); L[1] = tr_read<v_rd_off(D0, 1, 0)>(vb); H[1] = tr_read<v_rd_off(D0, 1, 1)>(vb); \
    L[2] = tr_read<v_rd_off(D0, 2, 0)>(vb); H[2] = tr_read<v_rd_off(D0, 2, 1)>(vb); L[3] = tr_read<v_rd_off(D0, 3, 0)>(vb); H[3] = tr_read<v_rd_off(D0, 3, 1)>(vb); } while (0)
#define PKV(L, H, k) (bf16x8){L[k][0], L[k][1], L[k][2], L[k][3], H[k][0], H[k][1], H[k][2], H[k][3]}
#define MM4(OD, L, H) do { OD = __builtin_amdgcn_mfma_f32_32x32x16_bf16(pa0, PKV(L, H, 0), OD, 0, 0, 0); OD = __builtin_amdgcn_mfma_f32_32x32x16_bf16(pa1, PKV(L, H, 1), OD, 0, 0, 0); \
    OD = __builtin_amdgcn_mfma_f32_32x32x16_bf16(pa2, PKV(L, H, 2), OD, 0, 0, 0); OD = __builtin_amdgcn_mfma_f32_32x32x16_bf16(pa3, PKV(L, H, 3), OD, 0, 0, 0); } while (0)
#define LWAIT() do { asm volatile("s_waitcnt lgkmcnt(0)" ::: "memory"); SBAR(); } while (0)
__device__ __forceinline__ void pv_exp(f32x16* o, int vb, bf16x8 pa0, bf16x8 pa1, bf16x8 pa2, bf16x8 pa3, f32x16& n0, f32x16& n1) {
  s16x4 lA[4], hA[4], lB[4], hB[4];
  RD8(0, lA, hA); LWAIT();
  RD8(1, lB, hB); MM4(o[0], lA, hA);
#pragma unroll
  for (int r = 0; r < 8; ++r) n0[r] = __builtin_amdgcn_exp2f(n0[r]);
  asm volatile("" : "+v"(n0)); LWAIT();
  RD8(2, lA, hA); MM4(o[1], lB, hB);
#pragma unroll
  for (int r = 8; r < 16; ++r) n0[r] = __builtin_amdgcn_exp2f(n0[r]);
  asm volatile("" : "+v"(n0)); LWAIT();
  RD8(3, lB, hB); MM4(o[2], lA, hA);
#pragma unroll
  for (int r = 0; r < 8; ++r) n1[r] = __builtin_amdgcn_exp2f(n1[r]);
  asm volatile("" : "+v"(n1)); LWAIT();
  MM4(o[3], lB, hB);
#pragma unroll
  for (int r = 8; r < 16; ++r) n1[r] = __builtin_amdgcn_exp2f(n1[r]);
  asm volatile("" : "+v"(n1)); SBAR();
}
#undef RD8
#undef PKV
#undef MM4
#undef LWAIT
__device__ __forceinline__ void pv_d0(f32x16* o, int vb, bf16x8 pa0, bf16x8 pa1, bf16x8 pa2, bf16x8 pa3) {
  pv_one<0>(o[0], vb, pa0, pa1, pa2, pa3); pv_one<1>(o[1], vb, pa0, pa1, pa2, pa3); pv_one<2>(o[2], vb, pa0, pa1, pa2, pa3); pv_one<3>(o[3], vb, pa0, pa1, pa2, pa3);
}
__device__ __forceinline__ void attn_unit(const bf16* __restrict__ P, bf16* __restrict__ MIXIN, const float* __restrict__ gn, int seq0, int h, int q0, int nt, float kmax0, float kmax1, float slope, float lam, char* lds) {
  int tid_ = threadIdx.x; asm volatile("" : "+v"(tid_)); const int tid = tid_, wid = tid >> 6, lane = tid & 63, r32 = lane & 31, hi = lane >> 5, mp = wid >> 2, wq = wid & 3;
  char* V_lds = lds; char* K_lds = lds + 2 * SHM_V;
  float* ws = (float*)(lds + 2 * SHM_V + 2 * SHM_K) + wid * 64; float* li_l = ws; float* al_l = ws + 32;
  float l_reg = 0; f32x16 o[4] = {}; bf16x8 qr[4];
  const int qpos = q0 + wq * 32 + r32;
  const bf16* Qw = P + (size_t)(seq0 + qpos) * LDP + C_DAQ + h * 128 + mp * 64 + hi * 8;
#pragma unroll
  for (int d0 = 0; d0 < 4; ++d0) qr[d0] = *reinterpret_cast<const bf16x8*>(Qw + d0 * 16);
  const bf16* Kh = P + (size_t)seq0 * LDP + C_DAK + h * 128;
  int t0, t1; float m_reg;
  { const bf16* Kw = Kh + (size_t)qpos * LDP + mp * 64 + hi * 8; float qn = 0.f, sd = 0.f;
#pragma unroll
    for (int d0 = 0; d0 < 4; ++d0) { const bf16x8 kf = *reinterpret_cast<const bf16x8*>(Kw + d0 * 16);
#pragma unroll
      for (int e = 0; e < 8; ++e) { const float qv = bf2f((unsigned short)qr[d0][e]), kv = bf2f((unsigned short)kf[e]); qn += qv * qv; sd += qv * kv; } }
    qn += __shfl_xor(qn, 32); sd += __shfl_xor(sd, 32);
    const float ub = sqrtf(qn) * (mp ? kmax1 : kmax0) * 1.0001f;
    m_reg = fminf(ub, sd + 60.f);
    float bnd = ub - sd;
    bnd = fmaxf(bnd, __shfl_xor(bnd, 1)); bnd = fmaxf(bnd, __shfl_xor(bnd, 2)); bnd = fmaxf(bnd, __shfl_xor(bnd, 4)); bnd = fmaxf(bnd, __shfl_xor(bnd, 8)); bnd = fmaxf(bnd, __shfl_xor(bnd, 16));
    float* wsb = (float*)(lds + 2 * SHM_V + 2 * SHM_K);
    if (lane == 0) wsb[wid] = bnd;
    __syncthreads();
    float B = wsb[0];
#pragma unroll
    for (int w = 1; w < 8; ++w) B = fmaxf(B, wsb[w]);
    const float Wf = fminf((B + 24.f * 1.4426950408889634f) / (slope * 1.4426950408889634f) + 1.f, 1.0e6f); const int Wi = (int)Wf;
    const int lo = q0 - Wi, hi_ = q0 + 127 + Wi;
    t0 = lo > 0 ? (lo >> 6) : 0; t1 = (hi_ >> 6) + 1; if (t1 > nt) t1 = nt;
    if ((t1 - t0) & 1) { if (t0 > 0) --t0; else ++t1; }
    __syncthreads(); }
  const bf16* Vh = P + (size_t)seq0 * LDP + C_DAV + h * 128;
  const int sr = tid >> 4, sc = (tid & 15) * 8, vst0 = v_st(sr, sc), vst1 = v_st(32 + sr, sc);
  const int vb0 = (int)(uintptr_t)V_lds + v_rd_base(lane);
  const float nsl2 = -slope * 1.4426950408889634f;
  const float dqb = (float)(qpos - 4 * hi);
  const int cbase = mp * 64;
  const int jlo_ = q0 >> 6, jhi_ = (q0 + 127) >> 6;
  bf16x8 vsA0, vsA1, ksA0, ksA1;
#define SLOADA(k0) do { vsA0 = *(const bf16x8*)(&Vh[(size_t)((k0) + sr) * LDP + sc]); vsA1 = *(const bf16x8*)(&Vh[(size_t)((k0) + 32 + sr) * LDP + sc]); \
    ksA0 = *(const bf16x8*)(&Kh[(size_t)((k0) + sr) * LDP + sc]); ksA1 = *(const bf16x8*)(&Kh[(size_t)((k0) + 32 + sr) * LDP + sc]); } while (0)
#define SLOADB(k0) do { vsB0 = *(const bf16x8*)(&Vh[(size_t)((k0) + sr) * LDP + sc]); vsB1 = *(const bf16x8*)(&Vh[(size_t)((k0) + 32 + sr) * LDP + sc]); \
    ksB0 = *(const bf16x8*)(&Kh[(size_t)((k0) + sr) * LDP + sc]); ksB1 = *(const bf16x8*)(&Kh[(size_t)((k0) + 32 + sr) * LDP + sc]); } while (0)
#define SWRITEA(b) do { *(bf16x8*)(V_lds + (b) * SHM_V + vst0) = vsA0; *(bf16x8*)(V_lds + (b) * SHM_V + vst1) = vsA1; const int kc = sc * 2; \
    *(bf16x8*)(K_lds + (b) * SHM_K + KSWZ(sr, kc)) = ksA0; *(bf16x8*)(K_lds + (b) * SHM_K + KSWZ(32 + sr, kc)) = ksA1; } while (0)
#define SWRITEB(b) do { *(bf16x8*)(V_lds + (b) * SHM_V + vst0) = vsB0; *(bf16x8*)(V_lds + (b) * SHM_V + vst1) = vsB1; const int kc = sc * 2; \
    *(bf16x8*)(K_lds + (b) * SHM_K + KSWZ(sr, kc)) = ksB0; *(bf16x8*)(K_lds + (b) * SHM_K + KSWZ(32 + sr, kc)) = ksB1; } while (0)
#define SWAIT() asm volatile("s_waitcnt vmcnt(4)" ::: "memory")
#define RESC(a) do { if (__any((a) < 1.f)) { if (hi == 0) al_l[r32] = (a); asm volatile("s_waitcnt lgkmcnt(0)" ::: "memory"); \
    _Pragma("unroll") for (int d = 0; d < 4; ++d) _Pragma("unroll") for (int r = 0; r < 16; ++r) o[d][r] *= al_l[crow(r, hi)]; } } while (0)
#define DQ(j) (dqb - 64.f * (float)(j))
#define SIDE(j) (((j) < jlo_) ? 1 : (((j) > jhi_) ? -1 : 0))
  f32x16 pA0, pA1, pB0, pB1; bf16x8 pa0, pa1, pa2, pa3;
  SLOADA(t0 * 64); asm volatile("s_waitcnt vmcnt(0)" ::: "memory"); SWRITEA(0); __syncthreads();
  SLOADA((t0 + 1) * 64);
  sc_init(pA0, pA1, DQ(t0), nsl2, m_reg, SIDE(t0)); qk_only(pA0, pA1, K_lds, qr, r32, hi, cbase);
#pragma unroll
  for (int r = 0; r < 16; ++r) { pA0[r] = __builtin_amdgcn_exp2f(pA0[r]); pA1[r] = __builtin_amdgcn_exp2f(pA1[r]); }
  asm volatile("s_waitcnt vmcnt(0)" ::: "memory"); SWRITEA(1); __syncthreads();
  for (int j = t0 + 1; j + 1 < t1; j += 2) {
    SLOADA((j + 1) * 64); SBAR();
    sc_init(pB0, pB1, DQ(j), nsl2, m_reg, SIDE(j)); SBAR();
    qk_fin(pB0, pB1, K_lds + SHM_K, qr, r32, hi, cbase, pA0, pA1, l_reg, pa0, pa1, pa2, pa3);
    pv_exp(o, vb0, pa0, pa1, pa2, pa3, pB0, pB1);
    __syncthreads(); asm volatile("s_waitcnt vmcnt(0)" ::: "memory"); SWRITEA(0); __syncthreads();
    if (j + 2 < t1) SLOADA((j + 2) * 64); SBAR();
    sc_init(pA0, pA1, DQ(j + 1), nsl2, m_reg, SIDE(j + 1)); SBAR();
    qk_fin(pA0, pA1, K_lds, qr, r32, hi, cbase, pB0, pB1, l_reg, pa0, pa1, pa2, pa3);
    pv_exp(o, vb0 + SHM_V, pa0, pa1, pa2, pa3, pA0, pA1);
    __syncthreads(); if (j + 2 < t1) { asm volatile("s_waitcnt vmcnt(0)" ::: "memory"); SWRITEA(1); } __syncthreads();
  }
  sc_init(pB0, pB1, DQ(t1 - 1), nsl2, m_reg, SIDE(t1 - 1)); SBAR();
  qk_fin(pB0, pB1, K_lds + SHM_K, qr, r32, hi, cbase, pA0, pA1, l_reg, pa0, pa1, pa2, pa3);
  pv_exp(o, vb0, pa0, pa1, pa2, pa3, pB0, pB1);
  fin_only(pB0, pB1, l_reg, pa0, pa1, pa2, pa3); SBAR();
  pv_d0(o, vb0 + SHM_V, pa0, pa1, pa2, pa3);
  int tide_ = threadIdx.x; asm volatile("" : "+v"(tide_)); const int lanee = tide_ & 63, r32e = lanee & 31, hie = lanee >> 5, wide = tide_ >> 6, wqe = wide & 3, mpe = wide >> 2;
  if (hie == 0) li_l[r32e] = l_reg; asm volatile("s_waitcnt lgkmcnt(0)" ::: "memory");
  float rli[16];
#pragma unroll
  for (int r = 0; r < 16; ++r) rli[r] = __builtin_amdgcn_rcpf(li_l[crow(r, hie)]);
  asm volatile("s_waitcnt vmcnt(0)" ::: "memory");
  __syncthreads();
  float* X = (float*)lds;
  if (mpe == 1) {
#pragma unroll
    for (int d0 = 0; d0 < 4; ++d0)
#pragma unroll
      for (int r = 0; r < 16; ++r) X[(wqe * 64 + d0 * 16 + r) * 64 + lanee] = o[d0][r] * rli[r] * lam;
  }
  __syncthreads();
  if (mpe == 0) {
    float g4[4];
#pragma unroll
    for (int d0 = 0; d0 < 4; ++d0) g4[d0] = gn[d0 * 32 + r32e] * 0.8f;
#pragma unroll
    for (int d0 = 0; d0 < 4; ++d0)
#pragma unroll
      for (int r = 0; r < 16; ++r) o[d0][r] = o[d0][r] * rli[r] - X[(wqe * 64 + d0 * 16 + r) * 64 + lanee];
    bf16* Ow = MIXIN + (size_t)(seq0 + q0 + wqe * 32) * DM + h * 128 + r32e;
#pragma unroll
    for (int r = 0; r < 16; ++r) {
      float ss = o[0][r] * o[0][r] + o[1][r] * o[1][r] + o[2][r] * o[2][r] + o[3][r] * o[3][r];
      ss += __shfl_xor(ss, 1); ss += __shfl_xor(ss, 2); ss += __shfl_xor(ss, 4); ss += __shfl_xor(ss, 8); ss += __shfl_xor(ss, 16);
      const float sc_ = 1.0f / sqrtf(ss * (1.0f / 128.0f) + EPS);
      const int orow = crow(r, hie);
#pragma unroll
      for (int d0 = 0; d0 < 4; ++d0) Ow[(size_t)orow * DM + d0 * 32] = (bf16)f2bf(o[d0][r] * sc_ * g4[d0]);
    }
  }
  __syncthreads();
#undef SLOADA
#undef SLOADB
#undef SWRITEA
#undef SWRITEB
#undef SWAIT
#undef RESC
#undef DQ
#undef SIDE
}
}

namespace gla {
#define LBAR() do { asm volatile("s_waitcnt lgkmcnt(0)" ::: "memory"); __builtin_amdgcn_s_barrier(); asm volatile("" ::: "memory"); } while (0)
constexpr int GS = 68;
constexpr int VS = 272;
constexpr int ST72 = 72;
constexpr int L_BD = 0, L_ATTF = 0, L_ATTB = 9216, L_V = 34816, L_SF = 52224, L_SB = 69632, L_QTF = 87040, L_QTB = 96256, L_KTF = 105472, L_KTB = 114688, L_RS = 123904;
typedef LAS const char* lcp;
typedef short v4i16_t __attribute__((ext_vector_type(4)));
__device__ __forceinline__ bf16x8 frag(lcp base, int row0, int k0, int lane) { return *(LAS const bf16x8*)(base + ((row0 + (lane & 31)) * ST72 + k0 + 8 * (lane >> 5)) * 2); }
__device__ __forceinline__ s16x4 tr4(lcp p) { return __builtin_bit_cast(s16x4, __builtin_amdgcn_ds_read_tr16_b64_v4i16((LAS v4i16_t*)p)); }
__device__ __forceinline__ bf16x8 trfrag(lcp base, int rs, int k0, int n0, int lane) {
  const int g = lane >> 4, r = (lane & 15) >> 2, c = lane & 3;
  lcp p = base + (k0 + 8 * (g >> 1) + r) * rs + (n0 + 16 * (g & 1) + 4 * c) * 2;
  const s16x4 lo = tr4(p), hi = tr4(p + 4 * rs);
  return (bf16x8){lo[0], lo[1], lo[2], lo[3], hi[0], hi[1], hi[2], hi[3]};
}
__device__ __forceinline__ float logsig(float z) { return fminf(z, 0.f) - __logf(1.0f + __expf(-__builtin_fabsf(z))); }
struct GPre { v4u kk, qq; v4u vv[4]; v4u sfv[4], sbv[4]; bf16x8 lr0, lr1, wb; float bias; unsigned short grv[16]; };
template <bool G3>
__device__ __forceinline__ void load_pre(GPre& R, const bf16* __restrict__ P, const Args& a, const bf16* __restrict__ WGT, const bf16* __restrict__ STATE, int n, int h) {
  int tid_ = threadIdx.x; asm volatile("" : "+v"(tid_)); const int tid = tid_, lane = tid & 63, wid = __builtin_amdgcn_readfirstlane(tid >> 6), r32 = lane & 31, hi = lane >> 5, row0 = n * 64, s = tid >> 3, dg = tid & 7;
  R.kk = *(const v4u*)(P + (size_t)(row0 + s) * LDP + C_GK + h * 64 + dg * 8);
  if (G3) { R.qq = *(const v4u*)(P + (size_t)(row0 + s) * LDP + C_GQ + h * 64 + dg * 8);
    const int ct_ = wid >> 2, et_ = wid & 3;
#pragma unroll
    for (int r = 0; r < 16; ++r) R.grv[r] = P[(size_t)(row0 + 32 * ct_ + crow(r, hi)) * LDP + C_GR + h * 128 + 32 * et_ + r32]; }
  if (wid < 4) { const int dir = wid >> 1, dt = wid & 1, c = h * 64 + 32 * dt + r32;
    R.wb = *(const bf16x8*)(WGT + ((size_t)dir * 256 + c) * 16 + 8 * hi); R.bias = (dir ? a.in[14] : a.in[12])[c];
    R.lr0 = *(const bf16x8*)(P + (size_t)(row0 + r32) * LDP + (dir ? C_LRB : C_LRF) + 8 * hi); R.lr1 = *(const bf16x8*)(P + (size_t)(row0 + 32 + r32) * LDP + (dir ? C_LRB : C_LRF) + 8 * hi);
  } else { const int t = tid - 256, s2 = t >> 2, part = t & 3;
    { const v4u* src = (const v4u*)(P + (size_t)(row0 + s2) * LDP + C_GV + h * 128 + part * 32); R.vv[0] = src[0]; R.vv[1] = src[1]; R.vv[2] = src[2]; R.vv[3] = src[3]; }
    if (G3) { const v4u* sf = (const v4u*)(STATE + ((size_t)(0 * NCHUNK + n) * 4 + h) * 8192 + s2 * 128 + part * 32); const v4u* sb = (const v4u*)(STATE + ((size_t)(1 * NCHUNK + n) * 4 + h) * 8192 + s2 * 128 + part * 32);
#pragma unroll
      for (int i = 0; i < 4; ++i) { R.sfv[i] = sf[i]; R.sbv[i] = sb[i]; } }
  }
}
template <bool WITH_S>
__device__ __forceinline__ void prep(const GPre& R, int n, int h, LAS char* lds) {
  int tid_ = threadIdx.x; asm volatile("" : "+v"(tid_)); const int tid = tid_, lane = tid & 63, wid = __builtin_amdgcn_readfirstlane(tid >> 6), r32 = lane & 31, hi = lane >> 5, row0 = n * 64;
  if (wid < 4) {
    const int dir = wid >> 1, dt = wid & 1;
    const bf16x8 bfr = R.wb;
    const float bias = R.bias;
    float g[32];
#pragma unroll
    for (int st = 0; st < 2; ++st) { const bf16x8 afr = st ? R.lr1 : R.lr0;
      f32x16 z = {}; z = __builtin_amdgcn_mfma_f32_32x32x16_bf16(afr, bfr, z, 0, 0, 0);
#pragma unroll
      for (int r = 0; r < 16; ++r) g[16 * st + r] = logsig(z[r] + bias) * 0.0625f; }
    float T[8], Tp[8];
    if (dir == 0) {
#pragma unroll
      for (int i = 0; i < 8; ++i) { g[4 * i + 1] += g[4 * i]; g[4 * i + 2] += g[4 * i + 1]; g[4 * i + 3] += g[4 * i + 2]; T[i] = g[4 * i + 3]; }
    } else {
#pragma unroll
      for (int i = 0; i < 8; ++i) { g[4 * i + 2] += g[4 * i + 3]; g[4 * i + 1] += g[4 * i + 2]; g[4 * i] += g[4 * i + 1]; T[i] = g[4 * i]; }
    }
#pragma unroll
    for (int i = 0; i < 8; ++i) Tp[i] = __shfl_xor(T[i], 32);
    if (dir == 0) { float run = 0.f;
#pragma unroll
      for (int i = 0; i < 8; ++i) { const float E = run + (hi ? Tp[i] : 0.f); run += T[i] + Tp[i];
#pragma unroll
        for (int q = 0; q < 4; ++q) g[4 * i + q] += E; }
    } else { float run = 0.f;
#pragma unroll
      for (int i = 7; i >= 0; --i) { const float E = run + (hi ? 0.f : Tp[i]); run += T[i] + Tp[i];
#pragma unroll
        for (int q = 0; q < 4; ++q) g[4 * i + q] += E; }
    }
    LAS float* B = (LAS float*)(lds + L_BD) + dir * 64 * GS + 32 * dt + r32;
#pragma unroll
    for (int i = 0; i < 8; ++i)
#pragma unroll
      for (int q = 0; q < 4; ++q) { const int s = 32 * (i >> 2) + q + 8 * (i & 3) + 4 * hi; B[s * GS] = g[4 * i + q]; }
  } else {
    const int t = tid - 256, s = t >> 2, part = t & 3;
    { LAS v4u* dst = (LAS v4u*)(lds + L_V + s * VS + part * 64); dst[0] = R.vv[0]; dst[1] = R.vv[1]; dst[2] = R.vv[2]; dst[3] = R.vv[3]; }
    if (WITH_S) { LAS v4u* df = (LAS v4u*)(lds + L_SF + s * VS + part * 64); LAS v4u* db = (LAS v4u*)(lds + L_SB + s * VS + part * 64);
#pragma unroll
      for (int i = 0; i < 4; ++i) { df[i] = R.sfv[i]; db[i] = R.sbv[i]; } }
  }
  LBAR();
}
__device__ __forceinline__ void g1_unit(const GPre& R, bf16* __restrict__ STATE, float* __restrict__ DEC, int n, int h, LAS char* lds) {
  int tid_ = threadIdx.x; asm volatile("" : "+v"(tid_)); const int tid = tid_, lane = tid & 63, wid = __builtin_amdgcn_readfirstlane(tid >> 6), s = tid >> 3, dg = tid & 7, row0 = n * 64;
  const v4u kk = R.kk;
  prep<false>(R, n, h, lds);
  { const LAS float* Bf = (const LAS float*)(lds + L_BD); const LAS float* Bb = Bf + 64 * GS;
    float kef[8], keb[8];
#pragma unroll
    for (int j = 0; j < 8; ++j) { const int d = dg * 8 + j; const float kv = (j & 1) ? bfhi(kk[j >> 1]) : bflo(kk[j >> 1]);
      const float bl = Bf[63 * GS + d], b0 = Bb[d];
      kef[j] = kv * __expf(bl - Bf[s * GS + d]); keb[j] = kv * __expf(b0 - Bb[s * GS + d]);
      if (s == 0) { DEC[((size_t)(0 * NCHUNK + n) * 4 + h) * 64 + d] = __expf(bl); DEC[((size_t)(1 * NCHUNK + n) * 4 + h) * 64 + d] = __expf(b0); } }
    v4u w;
    w.x = pk2(kef[0], kef[1]); w.y = pk2(kef[2], kef[3]); w.z = pk2(kef[4], kef[5]); w.w = pk2(kef[6], kef[7]); *(LAS v4u*)(lds + L_KTF + (s * ST72 + dg * 8) * 2) = w;
    w.x = pk2(keb[0], keb[1]); w.y = pk2(keb[2], keb[3]); w.z = pk2(keb[4], keb[5]); w.w = pk2(keb[6], keb[7]); *(LAS v4u*)(lds + L_KTB + (s * ST72 + dg * 8) * 2) = w; }
  LBAR();
  const int dt = wid >> 2, et = wid & 3, r32 = lane & 31, hi = lane >> 5;
#pragma unroll
  for (int dir = 0; dir < 2; ++dir) { f32x16 acc = {};
#pragma unroll
    for (int ks = 0; ks < 4; ++ks) acc = __builtin_amdgcn_mfma_f32_32x32x16_bf16(trfrag(lds + (dir ? L_KTB : L_KTF), ST72 * 2, 16 * ks, 32 * dt, lane), trfrag(lds + L_V, VS, 16 * ks, 32 * et, lane), acc, 0, 0, 0);
    bf16* So = STATE + ((size_t)(dir * NCHUNK + n) * 4 + h) * 8192;
#pragma unroll
    for (int r = 0; r < 16; ++r) So[(32 * dt + crow(r, hi)) * 128 + 32 * et + r32] = (bf16)f2bf(acc[r]); }
  LBAR();
}
__device__ __forceinline__ void g3_unit(const GPre& R, const float* __restrict__ gng, bf16* __restrict__ MIXIN, int n, int h, LAS char* lds) {
  int tid_ = threadIdx.x; asm volatile("" : "+v"(tid_)); const int tid = tid_, lane = tid & 63, wid = __builtin_amdgcn_readfirstlane(tid >> 6), s = tid >> 3, dg = tid & 7, row0 = n * 64, r32 = lane & 31, hi = lane >> 5;
  const v4u kk = R.kk, qq = R.qq;
  prep<true>(R, n, h, lds);
  { const LAS float* Bf = (const LAS float*)(lds + L_BD); const LAS float* Bb = Bf + 64 * GS;
    float qf[8], kf[8], qb[8], kb[8];
#pragma unroll
    for (int j = 0; j < 8; ++j) { const int d = dg * 8 + j; const float kv = (j & 1) ? bfhi(kk[j >> 1]) : bflo(kk[j >> 1]); const float qv = ((j & 1) ? bfhi(qq[j >> 1]) : bflo(qq[j >> 1])) * 0.125f;
      const float bf_ = Bf[s * GS + d], bb_ = Bb[s * GS + d];
      qf[j] = qv * __expf(bf_); kf[j] = kv * __expf(-bf_); qb[j] = qv * __expf(bb_); kb[j] = kv * __expf(-bb_); }
    v4u w;
    w.x = pk2(qf[0], qf[1]); w.y = pk2(qf[2], qf[3]); w.z = pk2(qf[4], qf[5]); w.w = pk2(qf[6], qf[7]); *(LAS v4u*)(lds + L_QTF + (s * ST72 + dg * 8) * 2) = w;
    w.x = pk2(qb[0], qb[1]); w.y = pk2(qb[2], qb[3]); w.z = pk2(qb[4], qb[5]); w.w = pk2(qb[6], qb[7]); *(LAS v4u*)(lds + L_QTB + (s * ST72 + dg * 8) * 2) = w;
    w.x = pk2(kf[0], kf[1]); w.y = pk2(kf[2], kf[3]); w.z = pk2(kf[4], kf[5]); w.w = pk2(kf[6], kf[7]); *(LAS v4u*)(lds + L_KTF + (s * ST72 + dg * 8) * 2) = w;
    w.x = pk2(kb[0], kb[1]); w.y = pk2(kb[2], kb[3]); w.z = pk2(kb[4], kb[5]); w.w = pk2(kb[6], kb[7]); *(LAS v4u*)(lds + L_KTB + (s * ST72 + dg * 8) * 2) = w; }
  LBAR();
  { const int dir = wid >> 2, ct = (wid >> 1) & 1, st = wid & 1; f32x16 acc = {};
    lcp Q = lds + (dir ? L_QTB : L_QTF); lcp K = lds + (dir ? L_KTB : L_KTF);
#pragma unroll
    for (int ks = 0; ks < 4; ++ks) acc = __builtin_amdgcn_mfma_f32_32x32x16_bf16(frag(Q, 32 * ct, 16 * ks, lane), frag(K, 32 * st, 16 * ks, lane), acc, 0, 0, 0);
    LAS bf16* ATT = (LAS bf16*)(lds + (dir ? L_ATTB : L_ATTF));
#pragma unroll
    for (int r = 0; r < 16; ++r) { const int c = 32 * ct + crow(r, hi), s_ = 32 * st + r32; const bool keep = dir ? (s_ > c) : (s_ <= c);
      ATT[c * ST72 + s_] = (bf16)f2bf(keep ? acc[r] : 0.f); } }
  LBAR();
  { const int ct = wid >> 2, et = wid & 3; f32x16 acc = {};
#pragma unroll
    for (int dir = 0; dir < 2; ++dir) { lcp ATT = lds + (dir ? L_ATTB : L_ATTF); lcp Q = lds + (dir ? L_QTB : L_QTF); lcp S = lds + (dir ? L_SB : L_SF);
#pragma unroll
      for (int ks = 0; ks < 4; ++ks) { acc = __builtin_amdgcn_mfma_f32_32x32x16_bf16(frag(ATT, 32 * ct, 16 * ks, lane), trfrag(lds + L_V, VS, 16 * ks, 32 * et, lane), acc, 0, 0, 0);
                                       acc = __builtin_amdgcn_mfma_f32_32x32x16_bf16(frag(Q, 32 * ct, 16 * ks, lane), trfrag(S, VS, 16 * ks, 32 * et, lane), acc, 0, 0, 0); } }
    LAS float* RS = (LAS float*)(lds + L_RS);
    float ssr[16];
#pragma unroll
    for (int r = 0; r < 16; ++r) { float ss = acc[r] * acc[r]; ss += __shfl_xor(ss, 1); ss += __shfl_xor(ss, 2); ss += __shfl_xor(ss, 4); ss += __shfl_xor(ss, 8); ss += __shfl_xor(ss, 16); ssr[r] = ss; }
    if (r32 == 0) {
#pragma unroll
      for (int r = 0; r < 16; ++r) RS[wid * 32 + crow(r, hi)] = ssr[r]; }
    LBAR();
    const int e = 32 * et + r32; const float g = gng[e];
#pragma unroll
    for (int r = 0; r < 16; ++r) { const int cl = crow(r, hi), c = 32 * ct + cl;
      const float tot = RS[(ct * 4 + 0) * 32 + cl] + RS[(ct * 4 + 1) * 32 + cl] + RS[(ct * 4 + 2) * 32 + cl] + RS[(ct * 4 + 3) * 32 + cl];
      const float sc_ = 1.0f / sqrtf(tot * (1.0f / 128.0f) + EPS);
      const float gr = bf2f(R.grv[r]);
      const float sl = gr * __builtin_amdgcn_rcpf(1.0f + __expf(-gr));
      MIXIN[(size_t)(row0 + c) * DM + 512 + h * 128 + e] = (bf16)f2bf(acc[r] * sc_ * g * sl); }
  }
  LBAR();
}
}

#define XB_TMO      128
#define XB_XCNT(j)  (256  + 64 * (j))
#define XB_XSUB(j)  (1280 + 64 * (j))
#define XB_XGEN(j)  (2304 + 64 * (j))
#define XB_TOP      3328
#define XB_TOPGEN   3392
#define XCD_BAR_WORDS 3456
#define XB_SPIN_CAP (1u << 18)

__device__ __forceinline__ unsigned xb_ld(unsigned* p)              { return __hip_atomic_load(p, __ATOMIC_RELAXED, __HIP_MEMORY_SCOPE_AGENT); }
__device__ __forceinline__ unsigned xb_add(unsigned* p, unsigned v) { return __hip_atomic_fetch_add(p, v, __ATOMIC_RELAXED, __HIP_MEMORY_SCOPE_AGENT); }
__device__ __forceinline__ unsigned xb_xcc_id() { return (unsigned)__builtin_amdgcn_s_getreg((3 << 11) | 20) & 0xFu; }
#define XB_SPIN(cond, bar) do { unsigned _sp = 0; while (cond) { __builtin_amdgcn_s_sleep(1); \
    if ((++_sp & 255u) == 0u) { if (xb_ld(&(bar)[XB_TMO])) break; if (_sp > XB_SPIN_CAP) { atomicAdd(&(bar)[XB_TMO], 1u); break; } } } } while (0)

struct XcdBarrier {
    unsigned* bar; unsigned x;
    volatile LAS unsigned* st;
};

__device__ __forceinline__ XcdBarrier xcd_barrier_post(unsigned* bar, volatile LAS unsigned* st) {
    XcdBarrier b; b.bar = bar; b.x = xb_xcc_id(); b.st = st;
    if (threadIdx.x == 0) (void)xb_add(&bar[XB_XCNT(b.x)], 1u);
    return b;
}
__device__ __forceinline__ void xcd_barrier_complete(unsigned* bar, unsigned x, unsigned& nloc, unsigned& nx) {
    const unsigned G = gridDim.x * gridDim.y * gridDim.z;
    unsigned sum, cnt, mine, sp = 0u;
    for (;;) {
        sum = 0u; cnt = 0u; mine = 0u;
#pragma unroll
        for (unsigned j = 0; j < 16; ++j) { const unsigned c = xb_ld(&bar[XB_XCNT(j)]); sum += c; cnt += (c > 0u) ? 1u : 0u; mine = (j == x) ? c : mine; }
        if (sum == G) break;
        __builtin_amdgcn_s_sleep(1);
        if ((++sp & 255u) == 0u) { if (xb_ld(&bar[XB_TMO])) break; if (sp > XB_SPIN_CAP) { atomicAdd(&bar[XB_TMO], 1u); break; } }
    }
    nloc = mine > 0u ? mine : 1u; nx = cnt > 0u ? cnt : 1u;
}

__device__ __forceinline__ void xcd_barrier(const XcdBarrier& b) {
    asm volatile("s_waitcnt vmcnt(0)" ::: "memory");
    __syncthreads();
    if (threadIdx.x == 0) {
        unsigned* bar = b.bar;
        __builtin_amdgcn_s_waitcnt(0);
        unsigned nloc = b.st[0], nx = b.st[1];
        if (nloc == 0u) { xcd_barrier_complete(bar, b.x, nloc, nx); b.st[0] = nloc; b.st[1] = nx; }
        const unsigned old = xb_add(&bar[XB_XSUB(b.x)], 1u);
        const unsigned gen = old / nloc;
        if (old + 1u == (gen + 1u) * nloc) {
            __builtin_amdgcn_fence(__ATOMIC_RELEASE, "agent");
            asm volatile("s_waitcnt vmcnt(0)" ::: "memory");
            const unsigned og = xb_add(&bar[XB_TOP], 1u);
            const unsigned tg = og / nx;
            if (og + 1u == (tg + 1u) * nx) xb_add(&bar[XB_TOPGEN], 1u);
            else XB_SPIN(xb_ld(&bar[XB_TOPGEN]) == tg, bar);
            __builtin_amdgcn_fence(__ATOMIC_ACQUIRE, "agent");
            xb_add(&bar[XB_XGEN(b.x)], 1u);
            asm volatile("s_waitcnt vmcnt(0)" ::: "memory");
        } else {
            XB_SPIN(xb_ld(&bar[XB_XGEN(b.x)]) == gen, bar);
            __builtin_amdgcn_fence(__ATOMIC_ACQUIRE, "agent");
            asm volatile("s_waitcnt vmcnt(0)" ::: "memory");
        }
    }
    __syncthreads();
}

__global__ void __launch_bounds__(NWAVES * 64, 2) hymba_fwd(Args args) {
    extern __shared__ __attribute__((aligned(16))) unsigned char lds[];
    cg::grid_group grid = cg::this_grid();
    LAS unsigned char* ldsl = (LAS unsigned char*)lds;
    volatile LAS unsigned* MISC = (volatile LAS unsigned*)(ldsl + MISC_OFF);
    const int tid = threadIdx.x, lane = tid & 63, wave = __builtin_amdgcn_readfirstlane(tid >> 6);
    const int G = gridDim.x, bid = blockIdx.x;
    const int gw = bid * NWAVES + wave, NGW = G * NWAVES;
    unsigned char* ws = args.ws;
    unsigned* ctl = (unsigned*)(ws + WS_CTL);
    bf16* Wup_t = (bf16*)(ws + WS_WUP); bf16* Wdown_t = (bf16*)(ws + WS_WDOWN); bf16* Win_t = (bf16*)(ws + WS_WIN); bf16* Wout_t = (bf16*)(ws + WS_WOUT);
    bf16* Wgate_t = (bf16*)(ws + WS_WGATE); bf16* Wproj_t = (bf16*)(ws + WS_WPROJ);
    bf16* H = (bf16*)(ws + WS_H); bf16* PROJ = (bf16*)(ws + WS_PROJ); bf16* MIX = (bf16*)(ws + WS_MIX); bf16* ACT = (bf16*)(ws + WS_ACT);
    bf16* X2B = (bf16*)(ws + WS_X2B); bf16* PB = (bf16*)(ws + WS_PB); bf16* GOUT = (bf16*)(ws + WS_GOUT); bf16* EOUT = (bf16*)(ws + WS_EOUT);
    float* DEC = (float*)(ws + WS_DEC); bf16* STATE = (bf16*)args.out;
    bf16* WGT = (bf16*)(ws + WS_WGT);
    float* OUT = args.out; bf16* X1B = (bf16*)args.out;
    if (tid < 32) MISC[tid] = 0u;
    __syncthreads();
    XcdBarrier xbar = xcd_barrier_post(ctl + CW_BAR, MISC + 8);
    if (gridDim.x > 65535u) grid.sync();

    {
        LAS float* scr = (LAS float*)(ldsl + wave * 16384);
        constexpr int I_IN = 16 * 97, I_OUT = 16 * 32, I_UP = 16 * 256, I_DOWN = 64 * 32, NITEMS = I_IN + I_OUT + I_UP + I_DOWN;
        for (int it = gw; it < NITEMS; it += NGW) {
            int r = it;
            if (r < I_IN) { const int kb = r / 97, nb = r % 97; transpose_item(args.in[5], 1024, 3104, Win_t, 64 * kb, 32 * nb, 32 * nb, scr, lane); continue; } r -= I_IN;
            if (r < I_OUT) { const int kb = r / 32, nb = r % 32; transpose_item(args.in[16], 1024, 1024, Wout_t, 64 * kb, 32 * nb, 32 * nb, scr, lane); continue; } r -= I_OUT;
            if (r < I_UP) { const int kb = r / 256, nb = r % 256; const int n0d = 32 * nb, pn = n0d >> 8, j = n0d & 255; const int n0s = (j < 128) ? (128 * pn + j) : (4096 + 128 * pn + (j - 128));
                transpose_item(args.in[19], 1024, 8192, Wup_t, 64 * kb, n0s, n0d, scr, lane); continue; } r -= I_UP;
            { const int kb = r / 32, nb = r % 32; transpose_item(args.in[22], 4096, 1024, Wdown_t, 64 * kb, 32 * nb, 32 * nb, scr, lane); }
        }
        { v4u z = {0u, 0u, 0u, 0u}; v4u* zp = (v4u*)(Win_t + (size_t)3104 * 1024); const int nz = 224 * 1024 * 2 / 16;
          for (int i = bid * 512 + tid; i < nz; i += G * 512) zp[i] = z; }
        { f32x4 gv[4];
#pragma unroll
          for (int j = 0; j < 4; ++j) gv[j] = *(const f32x4*)(args.in[4] + 4 * lane + 256 * j);
          for (int m = gw; m < MROWS; m += NGW) { const f32x4* xr = (const f32x4*)xrow_ptr(args, m) + lane; f32x4 v[4]; float s = 0.f;
#pragma unroll
            for (int j = 0; j < 4; ++j) { v[j] = __builtin_nontemporal_load(xr + 64 * j); s += (v[j].x * v[j].x + v[j].y * v[j].y) + (v[j].z * v[j].z + v[j].w * v[j].w); }
            const float rs = 1.0f / sqrtf(wave_sum(s) * (1.0f / DM) + EPS);
            v2u* o8 = (v2u*)(H + (size_t)m * DM) + lane;
#pragma unroll
            for (int j = 0; j < 4; ++j) { v2u w; w.x = pk2(v[j].x * rs * gv[j].x, v[j].y * rs * gv[j].y); w.y = pk2(v[j].z * rs * gv[j].z, v[j].w * rs * gv[j].w); o8[64 * j] = w; } } }
        for (int i = bid * 512 + tid; i < 8192; i += G * 512) { const int dir = i >> 12, c = (i >> 4) & 255, r = i & 15; WGT[i] = (bf16)f2bf((dir ? args.in[13] : args.in[11])[r * 256 + c]); }
        if (bid == 0 && wave == 0) { const float a1 = args.in[6][lane] * args.in[7][lane], a2 = args.in[8][lane] * args.in[9][lane];
            const float s1 = wave_sum(a1), s2 = wave_sum(a2); if (lane == 0) ((float*)ctl)[CW_LAM] = __expf(s1) - __expf(s2) + 0.2f; }
    }
    xcd_barrier(xbar);
    { pg8::Gemm g{H, Win_t, MROWS, LDP, 1024}; pg8::StaticOrder S; S.init(MROWS, LDP, G, bid); pg8::EpiBf16S E{PROJ, LDP, 2, 0.125f * 1.4426950408889634f};
      pg8::gemm_phase<pg8::EpiBf16S, pg8::StaticOrder, true, true>(ldsl, g, S, E); }
    xcd_barrier(xbar);
    {
      const int rpw = (MROWS + NGW - 1) / NGW; int m0 = gw * rpw, m1 = m0 + rpw; if (m1 > MROWS) m1 = MROWS;
      float mx = 0.f; int cs = -1;
      for (int m = m0; m < m1; ++m) { const int sq = m < NPROMPT ? (m >> 11) : 16;
        if (sq != cs) { if (cs >= 0 && (lane & 7) == 0) atomicMax(ctl + CW_NORM + cs * 16 + 8 + (lane >> 3), __float_as_uint(mx)); mx = 0.f; cs = sq; }
        const v4u a0 = *(const v4u*)(PROJ + (size_t)m * LDP + C_DAK + lane * 8);
        float ss = 0.f;
#pragma unroll
        for (int i = 0; i < 4; ++i) { const float x0 = bflo(a0[i]), x1 = bfhi(a0[i]); ss += x0 * x0 + x1 * x1; }
        ss += __shfl_xor(ss, 1); ss += __shfl_xor(ss, 2); ss += __shfl_xor(ss, 4); mx = fmaxf(mx, ss); }
      if (cs >= 0 && (lane & 7) == 0) atomicMax(ctl + CW_NORM + cs * 16 + 8 + (lane >> 3), __float_as_uint(mx)); }
    { gla::GPre cur, nxt; int u = bid;
      if (u < NCHUNK * 4) gla::load_pre<false>(cur, PROJ, args, WGT, STATE, u >> 2, u & 3);
      for (; u < NCHUNK * 4; u += G) { const int un = u + G;
        if (un < NCHUNK * 4) gla::load_pre<false>(nxt, PROJ, args, WGT, STATE, un >> 2, un & 3);
        gla::g1_unit(cur, STATE, DEC, u >> 2, u & 3, (LAS char*)ldsl); cur = nxt; } }
    xcd_barrier(xbar);
    {
        constexpr int NI = 2 * 68 * 32;
        for (int i = gw; i < NI; i += NGW) {
            const int sub = i & 31, t = i >> 5, dir = t & 1, sh = t >> 1;
            int n0, nc, h;
            if (sh < 4) { n0 = 512; nc = 256; h = sh; } else { const int v = sh - 4; n0 = 32 * (v >> 2); nc = 32; h = v & 3; }
            const size_t eoff = (size_t)sub * 256 + lane * 4; const int d = sub * 2 + (lane >> 5);
            f32x4 st = {0.f, 0.f, 0.f, 0.f};
            for (int k = 0; k < nc; k += 8) {
                v2u kv[8]; float dc[8];
#pragma unroll
                for (int q = 0; q < 8; ++q) { const int n = dir ? (n0 + nc - 1 - (k + q)) : (n0 + k + q); const size_t ch = (size_t)(dir * NCHUNK + n) * 4 + h;
                    kv[q] = *(const v2u*)(STATE + ch * 8192 + eoff); dc[q] = DEC[ch * 64 + d]; }
#pragma unroll
                for (int q = 0; q < 8; ++q) { const int n = dir ? (n0 + nc - 1 - (k + q)) : (n0 + k + q); const size_t ch = (size_t)(dir * NCHUNK + n) * 4 + h;
                    v2u w; w.x = pk2(st.x, st.y); w.y = pk2(st.z, st.w); *(v2u*)(STATE + ch * 8192 + eoff) = w;
                    const f32x4 kvf = {bflo(kv[q].x), bfhi(kv[q].x), bflo(kv[q].y), bfhi(kv[q].y)}; st = st * dc[q] + kvf; }
            }
        }
        __syncthreads();
        const float lam = ((const float*)ctl)[CW_LAM];
        constexpr int NU = 512 + 1024;
        for (;;) {
            if (tid == 0) MISC[0] = atomicAdd(ctl + CW_QCTR, 1u);
            __syncthreads();
            const int u = (int)MISC[0];
            __syncthreads();
            if (u >= NU) break;
            int seq0, h, q0, nt, sq;
            if (u < 512) { h = 3 - (u >> 7); q0 = (u & 127) * 128; seq0 = NPROMPT; nt = SS / 64; sq = 16; }
            else { const int v = u - 512; h = 3 - (v >> 8); sq = (v >> 4) & 15; q0 = (v & 15) * 128; seq0 = sq * SP; nt = SP / 64; }
            const float slope = (h == 0) ? 0.25f : (h == 1) ? 0.0625f : (h == 2) ? 0.015625f : 0.00390625f;
            const float kmax0 = sqrtf(__uint_as_float(__hip_atomic_load(ctl + CW_NORM + sq * 16 + 8 + h * 2 + 0, __ATOMIC_RELAXED, __HIP_MEMORY_SCOPE_AGENT)));
            const float kmax1 = sqrtf(__uint_as_float(__hip_atomic_load(ctl + CW_NORM + sq * 16 + 8 + h * 2 + 1, __ATOMIC_RELAXED, __HIP_MEMORY_SCOPE_AGENT)));
            da::attn_unit(PROJ, H, args.in[10], seq0, h, q0, nt, kmax0, kmax1, slope, lam, (char*)lds);
        }
    }
    xcd_barrier(xbar);
    { gla::GPre cur, nxt; int u = bid;
      if (u < NCHUNK * 4) gla::load_pre<true>(cur, PROJ, args, WGT, STATE, u >> 2, u & 3);
      for (; u < NCHUNK * 4; u += G) { const int un = u + G;
        if (un < NCHUNK * 4) gla::load_pre<true>(nxt, PROJ, args, WGT, STATE, un >> 2, un & 3);
        gla::g3_unit(cur, args.in[15], H, u >> 2, u & 3, (LAS char*)ldsl); cur = nxt; } }
    xcd_barrier(xbar);
    { pg8::Gemm g{H, Wout_t, MROWS, 1024, 1024}; pg8::StaticOrder S; S.init(MROWS, 1024, G, bid); pg8::EpiBf16S E{MIX, 1024, 0, 1.f};
      pg8::gemm_phase<pg8::EpiBf16S, pg8::StaticOrder, true, true>(ldsl, g, S, E); }
    xcd_barrier(xbar);
    {
      int tidf_ = threadIdx.x; asm volatile("" : "+v"(tidf_)); const int tid = tidf_, lane = tid & 63, wave = __builtin_amdgcn_readfirstlane(tid >> 6), gw = bid * NWAVES + wave; (void)tid; (void)wave;
      f32x4 g1[4], g2[4];
#pragma unroll
      for (int j = 0; j < 4; ++j) { g1[j] = *(const f32x4*)(args.in[17] + 4 * lane + 256 * j); g2[j] = *(const f32x4*)(args.in[18] + 4 * lane + 256 * j); }
      for (int m = gw; m < MROWS; m += NGW) { const f32x4* xr = (const f32x4*)xrow_ptr(args, m) + lane; const v2u* mr = (const v2u*)(MIX + (size_t)m * DM) + lane;
        f32x4 v[4], mx[4]; float s = 0.f;
#pragma unroll
        for (int j = 0; j < 4; ++j) { v[j] = __builtin_nontemporal_load(xr + 64 * j); const v2u w = __builtin_nontemporal_load(mr + 64 * j); mx[j] = (f32x4){bflo(w.x), bfhi(w.x), bflo(w.y), bfhi(w.y)};
          s += (mx[j].x * mx[j].x + mx[j].y * mx[j].y) + (mx[j].z * mx[j].z + mx[j].w * mx[j].w); }
        const float rs = 1.0f / sqrtf(wave_sum(s) * (1.0f / DM) + EPS); float s2 = 0.f;
        v2u* orow = (v2u*)(X1B + (size_t)m * DM) + lane;
#pragma unroll
        for (int j = 0; j < 4; ++j) { v[j] = v[j] + mx[j] * rs * g1[j]; { v2u w; w.x = pk2(v[j].x, v[j].y); w.y = pk2(v[j].z, v[j].w); __builtin_nontemporal_store(w, orow + 64 * j); } s2 += (v[j].x * v[j].x + v[j].y * v[j].y) + (v[j].z * v[j].z + v[j].w * v[j].w); }
        const float rs2 = 1.0f / sqrtf(wave_sum(s2) * (1.0f / DM) + EPS);
        v2u* o8 = (v2u*)(H + (size_t)m * DM) + lane;
        const int sm = m & 127; int crowi = -1;
        if (sm >= 126) crowi = 4 * (((m >> 7) + 1) % NGRP) + (sm - 126); else if (sm <= 1) crowi = 4 * (m >> 7) + 2 + sm;
        v2u* c8 = (v2u*)(H + (size_t)(MROWS + (crowi < 0 ? 0 : crowi)) * DM) + lane;
#pragma unroll
        for (int j = 0; j < 4; ++j) { v2u w; w.x = pk2(v[j].x * rs2 * g2[j].x, v[j].y * rs2 * g2[j].y); w.y = pk2(v[j].z * rs2 * g2[j].z, v[j].w * rs2 * g2[j].w); o8[64 * j] = w; if (crowi >= 0) c8[64 * j] = w; } } }
    xcd_barrier(xbar);
    { pg8::Gemm g{H, Wup_t, MROWS + NFIXROWS, 8192, 1024}; pg8::StaticOrder S; S.init(MROWS + NFIXROWS, 8192, G, bid); pg8::EpiConvGelu E{ACT, args.in[20], args.in[21], NMAINT, MROWS};
      pg8::gemm_phase<pg8::EpiConvGelu, pg8::StaticOrder, true, true, true>(ldsl, g, S, E); }
    xcd_barrier(xbar);
    { pg8::Gemm g{ACT, Wdown_t, MROWS, 1024, 4096}; pg8::StaticOrder S; S.init(MROWS, 1024, G, bid); pg8::EpiBf16S E{H, 1024, 0, 1.f};
      pg8::gemm_phase<pg8::EpiBf16S, pg8::StaticOrder, true, true>(ldsl, g, S, E); }
    xcd_barrier(xbar);
    {
      int tidf_ = threadIdx.x; asm volatile("" : "+v"(tidf_)); const int tid = tidf_, lane = tid & 63, wave = __builtin_amdgcn_readfirstlane(tid >> 6), gw = bid * NWAVES + wave; (void)tid; (void)wave;
        LAS float* scr = (LAS float*)(ldsl + wave * 16384);
        constexpr int I_G = 16 * 32, I_P = 4 * 32;
        for (int it = gw; it < I_G + I_P; it += NGW) {
            if (it < I_G) { const int kb = it / 32, nb = it % 32; transpose_item(args.in[24], 1024, 1024, Wgate_t, 64 * kb, 32 * nb, 32 * nb, scr, lane); }
            else { const int r = it - I_G; const int kb = r / 32, nb = r % 32; transpose_item(args.in[26], 256, 1024, Wproj_t, 64 * kb, 32 * nb, 32 * nb, scr, lane); }
        }
        f32x4 g1[4];
#pragma unroll
        for (int j = 0; j < 4; ++j) g1[j] = *(const f32x4*)(args.in[23] + 4 * lane + 256 * j);
        for (int m = gw; m < MROWS; m += NGW) { const v2u* xr = (const v2u*)(X1B + (size_t)m * DM) + lane; const v2u* mr = (const v2u*)(H + (size_t)m * DM) + lane;
            f32x4 v[4], mx[4]; float s = 0.f;
#pragma unroll
            for (int j = 0; j < 4; ++j) { { const v2u wx = __builtin_nontemporal_load(xr + 64 * j); v[j] = (f32x4){bflo(wx.x), bfhi(wx.x), bflo(wx.y), bfhi(wx.y)}; } const v2u w = __builtin_nontemporal_load(mr + 64 * j); mx[j] = (f32x4){bflo(w.x), bfhi(w.x), bflo(w.y), bfhi(w.y)};
              s += (mx[j].x * mx[j].x + mx[j].y * mx[j].y) + (mx[j].z * mx[j].z + mx[j].w * mx[j].w); }
            const float rs = 1.0f / sqrtf(wave_sum(s) * (1.0f / DM) + EPS);
            v2u* o8 = (v2u*)(X2B + (size_t)m * DM) + lane;
#pragma unroll
            for (int j = 0; j < 4; ++j) { v[j] = v[j] + mx[j] * rs * g1[j]; v2u w; w.x = pk2(v[j].x, v[j].y); w.y = pk2(v[j].z, v[j].w); o8[64 * j] = w; }
            const f32x4 pv = __builtin_nontemporal_load((const f32x4*)prow_ptr(args, m) + lane); v2u w; w.x = pk2(pv.x, pv.y); w.y = pk2(pv.z, pv.w); *((v2u*)(PB + (size_t)m * 256) + lane) = w; }
    }
    xcd_barrier(xbar);
    { pg8::Gemm g{X2B, Wgate_t, MROWS, 1024, 1024}; pg8::StaticOrder S; S.init(MROWS, 1024, G, bid); pg8::EpiBf16S E{GOUT, 1024, 0, 1.f};
      pg8::gemm_phase<pg8::EpiBf16S, pg8::StaticOrder, true, true>(ldsl, g, S, E); }
    __syncthreads();
    { pg8::Gemm g{PB, Wproj_t, MROWS, 1024, 256}; pg8::StaticOrder S; S.init(MROWS, 1024, G, bid); pg8::EpiBf16S E{EOUT, 1024, 0, 1.f};
      pg8::gemm_phase<pg8::EpiBf16S, pg8::StaticOrder, true, true>(ldsl, g, S, E); }
    xcd_barrier(xbar);
    {
      int tidf_ = threadIdx.x; asm volatile("" : "+v"(tidf_)); const int tid = tidf_, lane = tid & 63, wave = __builtin_amdgcn_readfirstlane(tid >> 6), gw = bid * NWAVES + wave; (void)tid; (void)wave;
      f32x4 ge[4], bg[4];
#pragma unroll
      for (int j = 0; j < 4; ++j) { ge[j] = *(const f32x4*)(args.in[27] + 4 * lane + 256 * j); bg[j] = *(const f32x4*)(args.in[25] + 4 * lane + 256 * j); }
      for (int m = gw; m < MROWS; m += NGW) { f32x4* xr = (f32x4*)(OUT + (size_t)m * DM) + lane; const v2u* x2r = (const v2u*)(X2B + (size_t)m * DM) + lane; const v2u* er = (const v2u*)(EOUT + (size_t)m * DM) + lane; const v2u* gr = (const v2u*)(GOUT + (size_t)m * DM) + lane;
        f32x4 v[4], ex[4], gx[4]; float s = 0.f;
#pragma unroll
        for (int j = 0; j < 4; ++j) { { const v2u wx = __builtin_nontemporal_load(x2r + 64 * j); v[j] = (f32x4){bflo(wx.x), bfhi(wx.x), bflo(wx.y), bfhi(wx.y)}; } const v2u w = __builtin_nontemporal_load(er + 64 * j); ex[j] = (f32x4){bflo(w.x), bfhi(w.x), bflo(w.y), bfhi(w.y)}; const v2u w2 = __builtin_nontemporal_load(gr + 64 * j); gx[j] = (f32x4){bflo(w2.x), bfhi(w2.x), bflo(w2.y), bfhi(w2.y)};
          s += (ex[j].x * ex[j].x + ex[j].y * ex[j].y) + (ex[j].z * ex[j].z + ex[j].w * ex[j].w); }
        const float rs = 1.0f / sqrtf(wave_sum(s) * (1.0f / DM) + EPS);
#pragma unroll
        for (int j = 0; j < 4; ++j) { f32x4 sg;
#pragma unroll
          for (int q = 0; q < 4; ++q) sg[q] = __builtin_amdgcn_rcpf(1.0f + __expf(-(gx[j][q] + bg[j][q])));
          __builtin_nontemporal_store(v[j] + sg * (ex[j] * rs * ge[j]), xr + 64 * j); } } }
}

extern "C" void kernel_launch(void* const* d_in, const int* in_sizes, int n_in, void* d_out, int out_size, void* d_ws, size_t ws_size, hipStream_t stream) {
    static int grid = 0;
    if (grid == 0) {
        if (n_in != 28 || out_size != MROWS * DM || ws_size < WS_END) { fprintf(stderr, "kernel_launch: unexpected shapes: n_in %d out %d ws %zu (need %zu)\n", n_in, out_size, ws_size, (size_t)WS_END); grid = -1; return; }
        int dev = 0, cus = 0, per_cu = 0;
        hipGetDevice(&dev); hipDeviceGetAttribute(&cus, hipDeviceAttributeMultiprocessorCount, dev);
        if (hipFuncSetAttribute((const void*)hymba_fwd, hipFuncAttributeMaxDynamicSharedMemorySize, LDS_BYTES) != hipSuccess) { fprintf(stderr, "kernel_launch: hipFuncSetAttribute failed\n"); grid = -1; return; }
        if (hipOccupancyMaxActiveBlocksPerMultiprocessor(&per_cu, (const void*)hymba_fwd, NWAVES * 64, LDS_BYTES) != hipSuccess || per_cu < 1) { fprintf(stderr, "kernel_launch: occupancy query failed (%d)\n", per_cu); per_cu = 1; }
        (void)hipGetLastError();
        grid = cus * per_cu;
    }
    if (grid < 0) return;
    (void)hipMemsetAsync((char*)d_ws + WS_CTL, 0, CTL_ZERO_BYTES, stream);
    Args a{};
    for (int i = 0; i < 28; ++i) a.in[i] = (const float*)d_in[i];
    a.out = (float*)d_out; a.ws = (unsigned char*)d_ws;
    void* kargs[] = {&a};
    hipError_t e = hipLaunchCooperativeKernel((const void*)hymba_fwd, dim3(grid), dim3(NWAVES * 64), kargs, LDS_BYTES, stream);
    if (e != hipSuccess) fprintf(stderr, "cooperative launch failed: %s (grid %d)\n", hipGetErrorString(e), grid);
}
```

```cpp
#include <hip/hip_runtime.h>
#include <hip/hip_cooperative_groups.h>
#include <cstdio>
#include <cstdint>
namespace cg = cooperative_groups;
namespace pg8 {
#define PG8_LAS __attribute__((address_space(3)))
typedef unsigned short bf16_t;
typedef short bf16x8 __attribute__((ext_vector_type(8)));
typedef float f32x4 __attribute__((ext_vector_type(4)));
typedef unsigned u32x4 __attribute__((ext_vector_type(4)));
constexpr int BM = 256, BK = 64, HALF = 128, HTB = HALF * BK * 2  , STAGE_BYTES = 8 * HTB, NXCD = 8, WGM = 8;

__host__ __device__ __forceinline__ int lds_byte(int r, int c) { const int st = (r >> 4) * 2 + (c >> 5), rr = r & 15, cc = c & 31, ob = rr * 64 + cc * 2; return st * 1024 + (ob ^ (((ob >> 9) & 1) << 5)); }
__host__ __device__ __forceinline__ void stage_rc(int b, int& R, int& C) { const int st = b / 1024, sb = b % 1024, swz = sb ^ (((sb >> 9) & 1) << 5); R = (st >> 1) * 16 + swz / 64; C = (st & 1) * 32 + (swz % 64) / 2; }
__host__ __device__ __forceinline__ int perm32(int rho) { const int n = rho >> 4, i = rho & 15; return 8 * (i >> 2) + 4 * n + (i & 3); }

struct Unit { int pm, pn; };
struct Gemm { const bf16_t* A; const bf16_t* Bt; int M, N, K; };

struct StaticOrder {
    int nM, nN, nwg, G, c;
    __host__ __device__ void init(int M, int N, int G_, int c_) { nM = M / BM; nN = N / BM; nwg = nM * nN; G = G_; c = c_; }
    __host__ __device__ bool next(int i, Unit& u) const {
        const long L = (long)i * G + c; if (L >= nwg) return false;
        int wgid = (int)L; { const int q = nwg / NXCD, r = nwg % NXCD, xcd = wgid % NXCD, off = wgid / NXCD; wgid = (xcd < r ? xcd * (q + 1) : r * (q + 1) + (xcd - r) * q) + off; }
        const int nig = WGM * nN, gid = wgid / nig, fm = gid * WGM, gsz = (nM - fm) < WGM ? (nM - fm) : WGM;
        u.pm = fm + ((wgid % nig) % gsz); u.pn = (wgid % nig) / gsz; return true;
    }
    __device__ __forceinline__ void a_ready(const Unit&) const {}
    __device__ __forceinline__ void done(const Unit&) const {}
};

__device__ __forceinline__ unsigned cvt_pk_bf16(float lo, float hi) { unsigned r; asm volatile("v_cvt_pk_bf16_f32 %0, %1, %2" : "=v"(r) : "v"(lo), "v"(hi)); return r; }
typedef float f32x2 __attribute__((ext_vector_type(2)));
typedef float f32x2 __attribute__((ext_vector_type(2)));
struct EpiBf16S {
    static constexpr bool PERM = true, AFTER_DRAIN = false;
    bf16_t* O; int ldc; int scale_tiles; float scale0;
    __device__ __forceinline__ void operator()(const f32x4 (&acc)[2][2][4][2], const Unit& u, int wr, int wc, int fr, int fq) const {
        const int row0 = u.pm * BM + wr * 64 + fr; const int col0 = u.pn * BM + wc * 32 + 8 * fq; const float sc = (u.pn < scale_tiles) ? scale0 : 1.f;
#pragma unroll
        for (int ai = 0; ai < 2; ++ai)
#pragma unroll
            for (int m = 0; m < 4; ++m) { bf16_t* rowp = O + (size_t)(row0 + ai * HALF + m * 16) * ldc + col0;
#pragma unroll
                for (int bj = 0; bj < 2; ++bj) { const f32x4 v0 = acc[ai][bj][m][0] * sc, v1 = acc[ai][bj][m][1] * sc;
                    u32x4 w; w.x = cvt_pk_bf16(v0[0], v0[1]); w.y = cvt_pk_bf16(v0[2], v0[3]); w.z = cvt_pk_bf16(v1[0], v1[1]); w.w = cvt_pk_bf16(v1[2], v1[3]);
                    __builtin_nontemporal_store(w, (u32x4*)(rowp + bj * HALF)); } }
    }
};
__device__ __forceinline__ float dpp_ror1(float v) { return __builtin_bit_cast(float, __builtin_amdgcn_update_dpp(0, __builtin_bit_cast(int, v), 0x121, 0xf, 0xf, false)); }
__device__ __forceinline__ float dpp_ror15(float v) { return __builtin_bit_cast(float, __builtin_amdgcn_update_dpp(0, __builtin_bit_cast(int, v), 0x12F, 0xf, 0xf, false)); }
__device__ __forceinline__ float gelu_tanh(float v) {
    const float inner = v * fmaf(0.044715f, v * v, 1.0f);
    const float e = __builtin_amdgcn_exp2f(inner * (-2.0f * 0.7978845608028654f * 1.4426950408889634f));
    return v * __builtin_amdgcn_rcpf(1.0f + e);
}
struct EpiConvGelu {
    static constexpr bool PERM = true, AFTER_DRAIN = false;
    bf16_t* ACT; const float* cw; const float* cb; int nmain; int mrows;
    __device__ __forceinline__ void operator()(const f32x4 (&acc)[2][2][4][2], const Unit& u, int wr, int wc, int fr, int fq) const {
        const bool fix = u.pm >= nmain;
        const int ch0 = u.pn * 128 + wc * 32 + 8 * fq;
        f32x4 w0[2], w1[2], w2[2], bb[2];
#pragma unroll
        for (int n = 0; n < 2; ++n) { w0[n] = *(const f32x4*)(cw + ch0 + 4 * n); w1[n] = *(const f32x4*)(cw + 4096 + ch0 + 4 * n); w2[n] = *(const f32x4*)(cw + 8192 + ch0 + 4 * n); bb[n] = *(const f32x4*)(cb + ch0 + 4 * n); }
#pragma unroll
        for (int ai = 0; ai < 2; ++ai)
#pragma unroll
            for (int m = 0; m < 4; ++m) {
                bool valid; int grow; bool zp = false, zn = false;
                if (!fix) { valid = !((ai == 0 && m == 0 && fr == 0) || (ai == 1 && m == 3 && fr == 15)); grow = u.pm * BM + wr * HALF + ai * 64 + m * 16 + fr; }
                else { const int R = (u.pm - nmain) * BM + wr * HALF + ai * 64 + m * 16 + fr; const int grp = R >> 2, pos = R & 3;
                    const bool ss = (grp < 256) ? ((grp & 15) == 0) : (grp == 256);
                    valid = (pos == 1) || (pos == 2); grow = (pos == 1) ? ((grp * 128 - 1 + mrows) % mrows) : (grp * 128);
                    zn = (pos == 1) && ss; zp = (pos == 2) && ss; }
                f32x4 res[2];
                const float fzp = zp ? 0.f : 1.f, fzn = zn ? 0.f : 1.f;
#pragma unroll
                for (int n = 0; n < 2; ++n) {
                    const f32x4 g = acc[ai][0][m][n], up = acc[ai][1][m][n];
                    f32x4 tp = g, tn = g;
                    if (!fix) { const f32x4 gm = (m > 0) ? acc[ai][0][m - 1][n] : acc[ai ^ 1][0][3][n], gx = (m < 3) ? acc[ai][0][m + 1][n] : acc[ai ^ 1][0][0][n];
                        tp = (fr == 15) ? gm : g; tn = (fr == 0) ? gx : g; }
                    f32x4 gp, gn;
#pragma unroll
                    for (int j = 0; j < 4; ++j) { gp[j] = dpp_ror1(tp[j]); gn[j] = dpp_ror15(tn[j]); }
                    const f32x4 cv = (w0[n] * fzp) * gp + (w1[n] * g + ((w2[n] * fzn) * gn + bb[n]));
                    const f32x4 inner = cv * (cv * cv * 0.044715f + 1.0f) * (-2.0f * 0.7978845608028654f * 1.4426950408889634f);
                    f32x4 sg;
#pragma unroll
                    for (int j = 0; j < 4; ++j) sg[j] = __builtin_amdgcn_rcpf(1.0f + __builtin_amdgcn_exp2f(inner[j]));
                    res[n] = cv * sg * up;
                }
                if (valid) { u32x4 w; w.x = cvt_pk_bf16(res[0][0], res[0][1]); w.y = cvt_pk_bf16(res[0][2], res[0][3]); w.z = cvt_pk_bf16(res[1][0], res[1][1]); w.w = cvt_pk_bf16(res[1][2], res[1][3]);
                    __builtin_nontemporal_store(w, (u32x4*)(ACT + (size_t)grow * 4096 + ch0)); }
            }
    }
};
template <class Epi, class Sched, bool ALIGN_EPI = false, bool SP2 = false, bool AROWS128 = false>
__device__ __forceinline__ void gemm_phase(PG8_LAS unsigned char* lds, const Gemm g, const Sched& S, const Epi& E) {
    int tid_ = threadIdx.x; asm volatile("" : "+v"(tid_)); const int tid = tid_, wid = __builtin_amdgcn_readfirstlane(tid >> 6), lane = tid & 63, wr = wid >> 2, wc = wid & 3, fr = lane & 15, fq = lane >> 4;
    const int K = g.K, nt = K / BK;
    unsigned voffA[2], voffB[2];
#pragma unroll
    for (int i = 0; i < 2; ++i) { int R, C; stage_rc(tid * 16 + i * 8192, R, C); const int Rb = Epi::PERM ? ((R & ~31) + perm32(R & 31)) : R;
        const int Ra = AROWS128 ? (128 * (R >> 6) + (R & 63)) : R;
        voffA[i] = (unsigned)(Ra * K + C) * 2u; voffB[i] = (unsigned)(Rb * K + C) * 2u; }
    const size_t kstep = (size_t)(BK * 2);
    const size_t hstep = (size_t)HALF * K * 2;
    const size_t tstep = 2 * hstep;
    const size_t hstepA = AROWS128 ? hstep / 2 : hstep;
    const unsigned ldsw = (unsigned)wid * 1024u;
    const int aoff = lds_byte(wr * 64 + fr, fq * 8), boff = lds_byte(wc * 32 + fr, fq * 8);
#define PG8_SA(b, h) (((b) * 2 + (h)) * HTB)
#define PG8_SB(b, h) ((4 + (b) * 2 + (h)) * HTB)
#define PG8_STAGE(bufoff, gbase, voff) do { _Pragma("unroll") for (int _i = 0; _i < 2; ++_i) \
        __builtin_amdgcn_global_load_lds((const unsigned*)((const char*)(gbase) + (voff)[_i]), (PG8_LAS unsigned*)(lds + (bufoff) + ldsw + _i * 8192), 16, 0, 0); } while (0)
#define PG8_LDA(dst, b, h) do { _Pragma("unroll") for (int m = 0; m < 4; ++m) _Pragma("unroll") for (int k = 0; k < 2; ++k) dst[m][k] = *(const PG8_LAS bf16x8*)(lds + PG8_SA(b, h) + aoff + m * 2048 + k * 1024); } while (0)
#define PG8_LDB(dst, b, h) do { _Pragma("unroll") for (int n = 0; n < 2; ++n) _Pragma("unroll") for (int k = 0; k < 2; ++k) dst[n][k] = *(const PG8_LAS bf16x8*)(lds + PG8_SB(b, h) + boff + n * 2048 + k * 1024); } while (0)
#define PG8_MMA(ai, bj, At, Bt) do { __builtin_amdgcn_s_setprio(1); _Pragma("unroll") for (int m = 0; m < 4; ++m) _Pragma("unroll") for (int n = 0; n < 2; ++n) _Pragma("unroll") for (int k = 0; k < 2; ++k) \
        acc[ai][bj][m][n] = __builtin_amdgcn_mfma_f32_16x16x32_bf16(Bt[n][k], At[m][k], acc[ai][bj][m][n], 0, 0, 0); __builtin_amdgcn_s_setprio(0); } while (0)
#define PG8_WAIT_V(n) asm volatile("s_waitcnt vmcnt(" #n ")" ::: "memory")
#define PG8_WAIT_L(n) asm volatile("s_waitcnt lgkmcnt(" #n ")" ::: "memory")
#define PG8_BAR __builtin_amdgcn_s_barrier()
#define PG8_SCHED __builtin_amdgcn_sched_barrier(0)
    Unit cur, nxt; int ui = 0;
    if (!S.next(0, cur)) return;
    f32x4 acc[2][2][4][2];
#pragma unroll
    for (int a = 0; a < 2; ++a)
#pragma unroll
        for (int b = 0; b < 2; ++b)
#pragma unroll
            for (int m = 0; m < 4; ++m)
#pragma unroll
                for (int n = 0; n < 2; ++n) acc[a][b][m][n] = (f32x4){0.f, 0.f, 0.f, 0.f};
    bf16x8 At[4][2], B0[2][2], B1[2][2];
    const char* cA = (const char*)g.A + (size_t)cur.pm * tstep; const char* cB = (const char*)g.Bt + (size_t)cur.pn * tstep;
    S.a_ready(cur);
    if constexpr (SP2) {
        PG8_STAGE(PG8_SB(0, 0), cB, voffB); PG8_STAGE(PG8_SB(0, 1), cB + hstep, voffB); PG8_STAGE(PG8_SA(0, 0), cA, voffA); PG8_STAGE(PG8_SA(0, 1), cA + hstepA, voffA);
        if (wr == 1) PG8_BAR;
        PG8_WAIT_V(2); PG8_BAR;
        PG8_STAGE(PG8_SB(1, 0), cB + kstep, voffB); PG8_STAGE(PG8_SA(1, 0), cA + kstep, voffA); PG8_STAGE(PG8_SB(1, 1), cB + hstep + kstep, voffB);
        PG8_WAIT_V(6); PG8_BAR;
    } else {
        PG8_STAGE(PG8_SB(0, 0), cB, voffB); PG8_STAGE(PG8_SA(0, 0), cA, voffA); PG8_STAGE(PG8_SB(0, 1), cB + hstep, voffB); PG8_STAGE(PG8_SA(0, 1), cA + hstepA, voffA);
        if (wr == 1) PG8_BAR;
        PG8_WAIT_V(4); PG8_BAR;
        PG8_STAGE(PG8_SB(1, 0), cB + kstep, voffB); PG8_STAGE(PG8_SA(1, 0), cA + kstep, voffA); PG8_STAGE(PG8_SB(1, 1), cB + hstep + kstep, voffB);
        PG8_WAIT_V(6); PG8_BAR;
    }
    for (;;) {
        const bool has_next = S.next(ui + 1, nxt);
        const char* nA = has_next ? (const char*)g.A + (size_t)nxt.pm * tstep : cA; const char* nB = has_next ? (const char*)g.Bt + (size_t)nxt.pn * tstep : cB;
        for (int t = 0; t < nt; t += 2) {
            const bool last = (t == nt - 2);
            const char* a1 = cA + (size_t)(t + 1) * kstep;
            const char* a2 = last ? nA : cA + (size_t)(t + 2) * kstep; const char* b2 = last ? nB : cB + (size_t)(t + 2) * kstep;
            const char* a3 = a2 + kstep; const char* b3 = b2 + kstep;
            if (last && has_next) S.a_ready(nxt);
            if constexpr (SP2) {
            PG8_LDB(B0, 0, 0); PG8_LDB(B1, 0, 1); PG8_SCHED; PG8_LDA(At, 0, 0); PG8_STAGE(PG8_SA(1, 1), a1 + hstepA, voffA);
            PG8_WAIT_V(8); PG8_WAIT_L(0); PG8_BAR; PG8_MMA(0, 0, At, B0); PG8_MMA(0, 1, At, B1); PG8_BAR; PG8_SCHED;
            PG8_LDA(At, 0, 1); PG8_STAGE(PG8_SB(0, 0), b2, voffB); PG8_STAGE(PG8_SB(0, 1), b2 + hstep, voffB); PG8_STAGE(PG8_SA(0, 0), a2, voffA);
            PG8_WAIT_V(8); PG8_WAIT_L(0); PG8_BAR; PG8_MMA(1, 0, At, B0); PG8_MMA(1, 1, At, B1); PG8_BAR; PG8_SCHED;
            PG8_LDB(B0, 1, 0); PG8_LDB(B1, 1, 1); PG8_SCHED; PG8_LDA(At, 1, 0); PG8_STAGE(PG8_SA(0, 1), a2 + hstepA, voffA);
            PG8_WAIT_V(8); PG8_WAIT_L(0); PG8_BAR; PG8_MMA(0, 0, At, B0); PG8_MMA(0, 1, At, B1); PG8_BAR; PG8_SCHED;
            PG8_LDA(At, 1, 1); PG8_STAGE(PG8_SB(1, 0), b3, voffB); PG8_STAGE(PG8_SB(1, 1), b3 + hstep, voffB); PG8_STAGE(PG8_SA(1, 0), a3, voffA);
            PG8_WAIT_V(8); PG8_WAIT_L(0); PG8_BAR; PG8_MMA(1, 0, At, B0); PG8_MMA(1, 1, At, B1); PG8_BAR; PG8_SCHED;
            } else {
            PG8_LDB(B0, 0, 0); PG8_SCHED; PG8_LDA(At, 0, 0); PG8_STAGE(PG8_SA(1, 1), a1 + hstepA, voffA);
            PG8_WAIT_L(8); PG8_BAR; PG8_WAIT_L(0); PG8_MMA(0, 0, At, B0); PG8_BAR; PG8_SCHED;
            PG8_LDB(B1, 0, 1); PG8_STAGE(PG8_SB(0, 0), b2, voffB);
            PG8_BAR; PG8_WAIT_L(0); PG8_MMA(0, 1, At, B1); PG8_BAR;
            PG8_LDA(At, 0, 1); PG8_STAGE(PG8_SA(0, 0), a2, voffA);
            PG8_BAR; PG8_WAIT_L(0); PG8_MMA(1, 0, At, B0); PG8_BAR; PG8_SCHED;
            PG8_STAGE(PG8_SB(0, 1), b2 + hstep, voffB);
            PG8_WAIT_V(6); PG8_BAR; PG8_MMA(1, 1, At, B1); PG8_BAR;
            PG8_LDB(B0, 1, 0); PG8_SCHED; PG8_LDA(At, 1, 0); PG8_STAGE(PG8_SA(0, 1), a2 + hstepA, voffA);
            PG8_WAIT_L(8); PG8_BAR; PG8_WAIT_L(0); PG8_MMA(0, 0, At, B0); PG8_BAR; PG8_SCHED;
            PG8_LDB(B1, 1, 1); PG8_STAGE(PG8_SB(1, 0), b3, voffB);
            PG8_BAR; PG8_WAIT_L(0); PG8_MMA(0, 1, At, B1); PG8_BAR;
            PG8_LDA(At, 1, 1); PG8_STAGE(PG8_SA(1, 0), a3, voffA);
            PG8_BAR; PG8_WAIT_L(0); PG8_MMA(1, 0, At, B0); PG8_BAR; PG8_SCHED;
            PG8_STAGE(PG8_SB(1, 1), b3 + hstep, voffB);
            PG8_WAIT_V(6); PG8_BAR; PG8_MMA(1, 1, At, B1); PG8_BAR;
            }
        }
        if constexpr (ALIGN_EPI) { if (wr == 0) PG8_BAR; }
        if constexpr (!Epi::AFTER_DRAIN) { E(acc, cur, wr, wc, fr, fq); S.done(cur); }
        if (!has_next) break;
#pragma unroll
        for (int a = 0; a < 2; ++a)
#pragma unroll
            for (int b = 0; b < 2; ++b)
#pragma unroll
                for (int m = 0; m < 4; ++m)
#pragma unroll
                    for (int n = 0; n < 2; ++n) acc[a][b][m][n] = (f32x4){0.f, 0.f, 0.f, 0.f};
        cur = nxt; cA = nA; cB = nB; ++ui;
        if constexpr (ALIGN_EPI) { if (wr == 1) PG8_BAR; }
    }
    PG8_WAIT_V(0);
    if constexpr (!ALIGN_EPI) { if (wr == 0) PG8_BAR; }
    PG8_BAR;
    if constexpr (Epi::AFTER_DRAIN) { E.fused(acc, cur, wr, wc, fr, fq, lds, wid, lane); S.done(cur); }
#undef PG8_SA
#undef PG8_SB
#undef PG8_STAGE
#undef PG8_LDA
#undef PG8_LDB
#undef PG8_MMA
#undef PG8_WAIT_V
#undef PG8_WAIT_L
#undef PG8_BAR
#undef PG8_SCHED
}
}

constexpr int DM = 1024, NPROMPT = 32768, NSAMPLE = 16384, MROWS = NPROMPT + NSAMPLE;
constexpr int SP = 2048, SS = 16384;
constexpr int LDP = 3328;
constexpr int C_DAQ = 0, C_DAK = 512, C_DAV = 1024, C_GQ = 1536, C_GK = 1792, C_GV = 2048, C_GR = 2560, C_LRF = 3072, C_LRB = 3088;
constexpr int DFF = 4096, NFIXROWS = 1536, NMAINT = MROWS / 256, NGRP = MROWS / 128;
constexpr float EPS = 1e-6f;
constexpr int NCHUNK = MROWS / 64;
constexpr size_t MiB = 1u << 20;
constexpr size_t WS_CTL = 0, WS_WUP = 1 * MiB, WS_WDOWN = 17 * MiB, WS_H = 25 * MiB, WS_ACT = 127 * MiB, WS_END = 511 * MiB;
constexpr size_t WS_PROJ = WS_ACT, WS_WIN = 439 * MiB, WS_WOUT = 446 * MiB, WS_DEC = 448 * MiB, WS_MIX = WS_ACT;
constexpr size_t WS_X2B = WS_ACT, WS_PB = 223 * MiB, WS_WGATE = 247 * MiB, WS_WPROJ = 249 * MiB, WS_GOUT = 250 * MiB, WS_EOUT = 346 * MiB;
constexpr size_t WS_WGT = 65536;
constexpr int CW_QCTR = 0, CW_LAM = 64, CW_NORM = 128, CW_BAR = 1024;
constexpr int CTL_ZERO_BYTES = 32768;
constexpr int RING_BYTES = 131072, MISC_OFF = RING_BYTES, LDS_BYTES = 147456;
constexpr int NWAVES = 8;

#define LAS __attribute__((address_space(3)))
typedef unsigned short bf16;
typedef unsigned v4u __attribute__((ext_vector_type(4)));
typedef unsigned v2u __attribute__((ext_vector_type(2)));
typedef float f32x4 __attribute__((ext_vector_type(4)));
typedef short bf16x8 __attribute__((ext_vector_type(8)));
typedef short s16x4 __attribute__((ext_vector_type(4)));
typedef float f32x16 __attribute__((ext_vector_type(16)));

__device__ __forceinline__ unsigned f2bf(float f) { unsigned u = __builtin_bit_cast(unsigned, f); return (u + 0x7fffu + ((u >> 16) & 1u)) >> 16; }
__device__ __forceinline__ unsigned pk2(float lo, float hi) { return f2bf(lo) | (f2bf(hi) << 16); }
__device__ __forceinline__ float bf2f(unsigned short b) { return __builtin_bit_cast(float, (unsigned)b << 16); }
__device__ __forceinline__ float bflo(unsigned w) { return __builtin_bit_cast(float, w << 16); }
__device__ __forceinline__ float bfhi(unsigned w) { return __builtin_bit_cast(float, w & 0xffff0000u); }
#define DPPF(v, ctrl, rmask) __builtin_bit_cast(float, __builtin_amdgcn_update_dpp(0, __builtin_bit_cast(int, (float)(v)), ctrl, rmask, 0xf, false))
__device__ __forceinline__ float wave_sum(float v) {
    v += DPPF(v, 0xB1, 0xf); v += DPPF(v, 0x4E, 0xf); v += DPPF(v, 0x141, 0xf); v += DPPF(v, 0x140, 0xf);
    v += DPPF(v, 0x142, 0xa); v += DPPF(v, 0x143, 0xc);
    return __builtin_bit_cast(float, __builtin_amdgcn_readlane(__builtin_bit_cast(int, v), 63));
}
__device__ __forceinline__ int crow(int r, int hi) { return (r & 3) + 8 * (r >> 2) + 4 * hi; }

struct Args {
    const float* in[28]; float* out; unsigned char* ws;
};

__device__ __forceinline__ void transpose_item(const float* W, int K, int N, bf16* WT, int k0, int n0src, int n0dst, LAS float* scr, int lane) {
#pragma unroll 8
    for (int i = 0; i < 32; ++i) { const int kk = 2 * i + (lane >> 5); scr[kk * 33 + (lane & 31)] = __builtin_nontemporal_load(W + (size_t)(k0 + kk) * N + n0src + (lane & 31)); }
    asm volatile("s_waitcnt lgkmcnt(0)" ::: "memory");
    const int c = lane & 7;
#pragma unroll
    for (int j = 0; j < 4; ++j) { const int n = (lane >> 3) + 8 * j; const LAS float* s = scr + (8 * c) * 33 + n;
        v4u o; o.x = pk2(s[0 * 33], s[1 * 33]); o.y = pk2(s[2 * 33], s[3 * 33]); o.z = pk2(s[4 * 33], s[5 * 33]); o.w = pk2(s[6 * 33], s[7 * 33]);
        *(v4u*)(WT + (size_t)(n0dst + n) * K + k0 + 8 * c) = o; }
    asm volatile("s_waitcnt lgkmcnt(0)" ::: "memory");
}
__device__ __forceinline__ const float* xrow_ptr(const Args& a, int row) { return row < NPROMPT ? a.in[0] + (size_t)row * DM : a.in[1] + (size_t)(row - NPROMPT) * DM; }
__device__ __forceinline__ const float* prow_ptr(const Args& a, int row) { return row < NPROMPT ? a.in[2] + (size_t)row * 256 : a.in[3] + (size_t)(row - NPROMPT) * 256; }

namespace da {
constexpr int SHM_V = 16384, SHM_K = 16384;
constexpr float THRL = 0.0f;
#define KSWZ(row, colB) ((row) * 256 + ((colB) ^ (((row) & 7) << 4)))
#define SBAR() __builtin_amdgcn_sched_barrier(0)
__device__ __forceinline__ unsigned cvtpk(float lo, float hi) { unsigned r; asm volatile("v_cvt_pk_bf16_f32 %0, %1, %2" : "=v"(r) : "v"(lo), "v"(hi)); return r; }
#define PK4(P, BASE, OUT) do { unsigned a0 = cvtpk(P[BASE + 0], P[BASE + 1]), a1 = cvtpk(P[BASE + 2], P[BASE + 3]);   \
    unsigned b0 = cvtpk(P[BASE + 4], P[BASE + 5]), b1 = cvtpk(P[BASE + 6], P[BASE + 7]);                              \
    auto r0 = __builtin_amdgcn_permlane32_swap(a0, b0, false, false); auto r1 = __builtin_amdgcn_permlane32_swap(a1, b1, false, false); \
    v4u w = {r0[0], r1[0], r0[1], r1[1]}; OUT = *reinterpret_cast<bf16x8*>(&w); } while (0)
__device__ __forceinline__ void sc_init(f32x16& p0, f32x16& p1, float dq, float nsl2, float m_ref, int side) {
  if (side != 0) { const float sg = (float)side; const float base0 = fmaf(sg * nsl2, dq, -m_ref), base1 = base0 - sg * 32.f * nsl2;
#pragma unroll
    for (int r = 0; r < 16; ++r) { const float c = -sg * nsl2 * (float)((r & 3) + 8 * (r >> 2)); p0[r] = base0 + c; p1[r] = base1 + c; }
  } else {
#pragma unroll
    for (int r = 0; r < 16; ++r) { const float kv = (float)((r & 3) + 8 * (r >> 2)); const float d0 = dq - kv, d1 = d0 - 32.f;
      p0[r] = fmaf(nsl2, __builtin_fabsf(d0), -m_ref); p1[r] = fmaf(nsl2, __builtin_fabsf(d1), -m_ref); }
  }
}
#define KFRAG(d0, which) (*reinterpret_cast<const bf16x8*>(Ks + KSWZ((which) * 32 + r32, (cbase + (d0) * 16 + hi * 8) * 2)))
__device__ __forceinline__ void qk_only(f32x16& p0, f32x16& p1, const char* Ks, const bf16x8* qr, int r32, int hi, int cbase) {
#pragma unroll
  for (int d0 = 0; d0 < 4; ++d0) { const bf16x8 b0 = KFRAG(d0, 0), b1 = KFRAG(d0, 1);
    p0 = __builtin_amdgcn_mfma_f32_32x32x16_bf16(b0, qr[d0], p0, 0, 0, 0); p1 = __builtin_amdgcn_mfma_f32_32x32x16_bf16(b1, qr[d0], p1, 0, 0, 0); }
}
__device__ __forceinline__ void qk_fin(f32x16& n0, f32x16& n1, const char* Ks, const bf16x8* qr, int r32, int hi, int cbase,
                                       const f32x16& q0, const f32x16& q1, float& l_reg, bf16x8& pa0, bf16x8& pa1, bf16x8& pa2, bf16x8& pa3) {
  float ps = 0.f;
  { const bf16x8 k0 = KFRAG(0, 0), k1 = KFRAG(0, 1); n0 = __builtin_amdgcn_mfma_f32_32x32x16_bf16(k0, qr[0], n0, 0, 0, 0); n1 = __builtin_amdgcn_mfma_f32_32x32x16_bf16(k1, qr[0], n1, 0, 0, 0); }
#pragma unroll
  for (int r = 0; r < 8; ++r) ps += q0[r];
  PK4(q0, 0, pa0); asm volatile("" : "+v"(pa0), "+v"(ps)); SBAR();
  { const bf16x8 k0 = KFRAG(1, 0), k1 = KFRAG(1, 1); n0 = __builtin_amdgcn_mfma_f32_32x32x16_bf16(k0, qr[1], n0, 0, 0, 0); n1 = __builtin_amdgcn_mfma_f32_32x32x16_bf16(k1, qr[1], n1, 0, 0, 0); }
#pragma unroll
  for (int r = 8; r < 16; ++r) ps += q0[r];
  PK4(q0, 8, pa1); asm volatile("" : "+v"(pa1), "+v"(ps)); SBAR();
  { const bf16x8 k0 = KFRAG(2, 0), k1 = KFRAG(2, 1); n0 = __builtin_amdgcn_mfma_f32_32x32x16_bf16(k0, qr[2], n0, 0, 0, 0); n1 = __builtin_amdgcn_mfma_f32_32x32x16_bf16(k1, qr[2], n1, 0, 0, 0); }
#pragma unroll
  for (int r = 0; r < 8; ++r) ps += q1[r];
  PK4(q1, 0, pa2); asm volatile("" : "+v"(pa2), "+v"(ps)); SBAR();
  { const bf16x8 k0 = KFRAG(3, 0), k1 = KFRAG(3, 1); n0 = __builtin_amdgcn_mfma_f32_32x32x16_bf16(k0, qr[3], n0, 0, 0, 0); n1 = __builtin_amdgcn_mfma_f32_32x32x16_bf16(k1, qr[3], n1, 0, 0, 0); }
#pragma unroll
  for (int r = 8; r < 16; ++r) ps += q1[r];
  PK4(q1, 8, pa3);
  { auto rr = __builtin_amdgcn_permlane32_swap(__float_as_uint(ps), __float_as_uint(ps), false, false); ps = __uint_as_float(rr[0]) + __uint_as_float(rr[1]); }
  l_reg += ps; SBAR();
}
__device__ __forceinline__ void fin_only(const f32x16& q0, const f32x16& q1, float& l_reg, bf16x8& pa0, bf16x8& pa1, bf16x8& pa2, bf16x8& pa3) {
  float ps = 0.f;
#pragma unroll
  for (int r = 0; r < 16; ++r) ps += q0[r];
#pragma unroll
  for (int r = 0; r < 16; ++r) ps += q1[r];
  { auto rr = __builtin_amdgcn_permlane32_swap(__float_as_uint(ps), __float_as_uint(ps), false, false); ps = __uint_as_float(rr[0]) + __uint_as_float(rr[1]); }
  l_reg += ps; PK4(q0, 0, pa0); PK4(q0, 8, pa1); PK4(q1, 0, pa2); PK4(q1, 8, pa3);
}
__device__ __forceinline__ int v_st(int k, int c) { const int kk = (k & ~0xC) | ((k & 4) << 1) | ((k & 8) >> 1); return ((kk >> 3) * 4 + (c >> 5)) * 512 + ((kk & 7) * 32 + (c & 31)) * 2; }
__device__ __forceinline__ int v_rd_base(int lane) { return ((lane & 3) << 3) | (((lane >> 2) & 3) << 6) | (((lane >> 4) & 1) << 5) | (((lane >> 5) & 1) << 8); }
constexpr int v_rd_off(int d0, int ks, int half) { return d0 * 512 + ks * 4096 + half * 2048; }
template <int OFF> __device__ __forceinline__ s16x4 tr_read(int vb) {
  s16x4 r; asm volatile("ds_read_b64_tr_b16 %0, %1 offset:%2" : "=&v"(r) : "v"(vb), "i"(OFF) : "memory"); return r;
}
template <int D0> __device__ __forceinline__ void pv_one(f32x16& od, int vb, bf16x8 pa0, bf16x8 pa1, bf16x8 pa2, bf16x8 pa3) {
  const s16x4 l0 = tr_read<v_rd_off(D0, 0, 0)>(vb), h0 = tr_read<v_rd_off(D0, 0, 1)>(vb), l1 = tr_read<v_rd_off(D0, 1, 0)>(vb), h1 = tr_read<v_rd_off(D0, 1, 1)>(vb);
  const s16x4 l2 = tr_read<v_rd_off(D0, 2, 0)>(vb), h2 = tr_read<v_rd_off(D0, 2, 1)>(vb), l3 = tr_read<v_rd_off(D0, 3, 0)>(vb), h3 = tr_read<v_rd_off(D0, 3, 1)>(vb);
  asm volatile("s_waitcnt lgkmcnt(0)" ::: "memory"); SBAR();
#define PK(L, H) (bf16x8){L[0], L[1], L[2], L[3], H[0], H[1], H[2], H[3]}
  od = __builtin_amdgcn_mfma_f32_32x32x16_bf16(pa0, PK(l0, h0), od, 0, 0, 0);
  od = __builtin_amdgcn_mfma_f32_32x32x16_bf16(pa1, PK(l1, h1), od, 0, 0, 0);
  od = __builtin_amdgcn_mfma_f32_32x32x16_bf16(pa2, PK(l2, h2), od, 0, 0, 0);
  od = __builtin_amdgcn_mfma_f32_32x32x16_bf16(pa3, PK(l3, h3), od, 0, 0, 0);
#undef PK
}
__device__ __forceinline__ void pv_exp(f32x16* o, int vb, bf16x8 pa0, bf16x8 pa1, bf16x8 pa2, bf16x8 pa3, f32x16& n0, f32x16& n1) {
  pv_one<0>(o[0], vb, pa0, pa1, pa2, pa3);
#pragma unroll
  for (int r = 0; r < 8; ++r) n0[r] = __builtin_amdgcn_exp2f(n0[r]);
  asm volatile("" : "+v"(n0)); SBAR(); pv_one<1>(o[1], vb, pa0, pa1, pa2, pa3);
#pragma unroll
  for (int r = 8; r < 16; ++r) n0[r] = __builtin_amdgcn_exp2f(n0[r]);
  asm volatile("" : "+v"(n0)); SBAR(); pv_one<2>(o[2], vb, pa0, pa1, pa2, pa3);
#pragma unroll
  for (int r = 0; r < 8; ++r) n1[r] = __builtin_amdgcn_exp2f(n1[r]);
  asm volatile("" : "+v"(n1)); SBAR(); pv_one<3>(o[3], vb, pa0, pa1, pa2, pa3);
#pragma unroll
  for (int r = 8; r < 16; ++r) n1[r] = __builtin_amdgcn_exp2f(n1[r]);
  asm volatile("" : "+v"(n1)); SBAR();
}
__device__ __forceinline__ void pv_d0(f32x16* o, int vb, bf16x8 pa0, bf16x8 pa1, bf16x8 pa2, bf16x8 pa3) {
  pv_one<0>(o[0], vb, pa0, pa1, pa2, pa3); pv_one<1>(o[1], vb, pa0, pa1, pa2, pa3); pv_one<2>(o[2], vb, pa0, pa1, pa2, pa3); pv_one<3>(o[3], vb, pa0, pa1, pa2, pa3);
}
__device__ __forceinline__ void attn_unit(const bf16* __restrict__ P, bf16* __restrict__ MIXIN, const float* __restrict__ gn, int seq0, int h, int q0, int nt, float kmax0, float kmax1, float slope, float lam, char* lds) {
  int tid_ = threadIdx.x; asm volatile("" : "+v"(tid_)); const int tid = tid_, wid = tid >> 6, lane = tid & 63, r32 = lane & 31, hi = lane >> 5, mp = wid >> 2, wq = wid & 3;
  char* V_lds = lds; char* K_lds = lds + 2 * SHM_V;
  float* ws = (float*)(lds + 2 * SHM_V + 2 * SHM_K) + wid * 64; float* li_l = ws; float* al_l = ws + 32;
  float l_reg = 0; f32x16 o[4] = {}; bf16x8 qr[4];
  const int qpos = q0 + wq * 32 + r32;
  const bf16* Qw = P + (size_t)(seq0 + qpos) * LDP + C_DAQ + h * 128 + mp * 64 + hi * 8;
#pragma unroll
  for (int d0 = 0; d0 < 4; ++d0) qr[d0] = *reinterpret_cast<const bf16x8*>(Qw + d0 * 16);
  const bf16* Kh = P + (size_t)seq0 * LDP + C_DAK + h * 128;
  int t0, t1; float m_reg;
  { const bf16* Kw = Kh + (size_t)qpos * LDP + mp * 64 + hi * 8; float qn = 0.f, sd = 0.f;
#pragma unroll
    for (int d0 = 0; d0 < 4; ++d0) { const bf16x8 kf = *reinterpret_cast<const bf16x8*>(Kw + d0 * 16);
#pragma unroll
      for (int e = 0; e < 8; ++e) { const float qv = bf2f((unsigned short)qr[d0][e]), kv = bf2f((unsigned short)kf[e]); qn += qv * qv; sd += qv * kv; } }
    qn += __shfl_xor(qn, 32); sd += __shfl_xor(sd, 32);
    const float ub = sqrtf(qn) * (mp ? kmax1 : kmax0) * 1.0001f;
    m_reg = fminf(ub, sd + 60.f);
    float bnd = ub - sd;
    bnd = fmaxf(bnd, __shfl_xor(bnd, 1)); bnd = fmaxf(bnd, __shfl_xor(bnd, 2)); bnd = fmaxf(bnd, __shfl_xor(bnd, 4)); bnd = fmaxf(bnd, __shfl_xor(bnd, 8)); bnd = fmaxf(bnd, __shfl_xor(bnd, 16));
    float* wsb = (float*)(lds + 2 * SHM_V + 2 * SHM_K);
    if (lane == 0) wsb[wid] = bnd;
    __syncthreads();
    float B = wsb[0];
#pragma unroll
    for (int w = 1; w < 8; ++w) B = fmaxf(B, wsb[w]);
    const float Wf = fminf((B + 24.f * 1.4426950408889634f) / (slope * 1.4426950408889634f) + 1.f, 1.0e6f); const int Wi = (int)Wf;
    const int lo = q0 - Wi, hi_ = q0 + 127 + Wi;
    t0 = lo > 0 ? (lo >> 6) : 0; t1 = (hi_ >> 6) + 1; if (t1 > nt) t1 = nt;
    if ((t1 - t0) & 1) { if (t0 > 0) --t0; else ++t1; }
    __syncthreads(); }
  const bf16* Vh = P + (size_t)seq0 * LDP + C_DAV + h * 128;
  const int sr = tid >> 4, sc = (tid & 15) * 8, vst0 = v_st(sr, sc), vst1 = v_st(32 + sr, sc);
  const int vb0 = (int)(uintptr_t)V_lds + v_rd_base(lane);
  const float nsl2 = -slope * 1.4426950408889634f;
  const float dqb = (float)(qpos - 4 * hi);
  const int cbase = mp * 64;
  const int jlo_ = q0 >> 6, jhi_ = (q0 + 127) >> 6;
  bf16x8 vsA0, vsA1, ksA0, ksA1, vsB0, vsB1, ksB0, ksB1;
#define SLOADA(k0) do { vsA0 = *(const bf16x8*)(&Vh[(size_t)((k0) + sr) * LDP + sc]); vsA1 = *(const bf16x8*)(&Vh[(size_t)((k0) + 32 + sr) * LDP + sc]); \
    ksA0 = *(const bf16x8*)(&Kh[(size_t)((k0) + sr) * LDP + sc]); ksA1 = *(const bf16x8*)(&Kh[(size_t)((k0) + 32 + sr) * LDP + sc]); } while (0)
#define SLOADB(k0) do { vsB0 = *(const bf16x8*)(&Vh[(size_t)((k0) + sr) * LDP + sc]); vsB1 = *(const bf16x8*)(&Vh[(size_t)((k0) + 32 + sr) * LDP + sc]); \
    ksB0 = *(const bf16x8*)(&Kh[(size_t)((k0) + sr) * LDP + sc]); ksB1 = *(const bf16x8*)(&Kh[(size_t)((k0) + 32 + sr) * LDP + sc]); } while (0)
#define SWRITEA(b) do { *(bf16x8*)(V_lds + (b) * SHM_V + vst0) = vsA0; *(bf16x8*)(V_lds + (b) * SHM_V + vst1) = vsA1; const int kc = sc * 2; \
    *(bf16x8*)(K_lds + (b) * SHM_K + KSWZ(sr, kc)) = ksA0; *(bf16x8*)(K_lds + (b) * SHM_K + KSWZ(32 + sr, kc)) = ksA1; } while (0)
#define SWRITEB(b) do { *(bf16x8*)(V_lds + (b) * SHM_V + vst0) = vsB0; *(bf16x8*)(V_lds + (b) * SHM_V + vst1) = vsB1; const int kc = sc * 2; \
    *(bf16x8*)(K_lds + (b) * SHM_K + KSWZ(sr, kc)) = ksB0; *(bf16x8*)(K_lds + (b) * SHM_K + KSWZ(32 + sr, kc)) = ksB1; } while (0)
#define SWAIT() asm volatile("s_waitcnt vmcnt(4)" ::: "memory")
#define RESC(a) do { if (__any((a) < 1.f)) { if (hi == 0) al_l[r32] = (a); asm volatile("s_waitcnt lgkmcnt(0)" ::: "memory"); \
    _Pragma("unroll") for (int d = 0; d < 4; ++d) _Pragma("unroll") for (int r = 0; r < 16; ++r) o[d][r] *= al_l[crow(r, hi)]; } } while (0)
#define DQ(j) (dqb - 64.f * (float)(j))
#define SIDE(j) (((j) < jlo_) ? 1 : (((j) > jhi_) ? -1 : 0))
  f32x16 pA0, pA1, pB0, pB1; bf16x8 pa0, pa1, pa2, pa3;
  SLOADA(t0 * 64); asm volatile("s_waitcnt vmcnt(0)" ::: "memory"); SWRITEA(0); __syncthreads();
  SLOADB((t0 + 1) * 64); if (t0 + 2 < t1) SLOADA((t0 + 2) * 64);
  sc_init(pA0, pA1, DQ(t0), nsl2, m_reg, SIDE(t0)); qk_only(pA0, pA1, K_lds, qr, r32, hi, cbase);
#pragma unroll
  for (int r = 0; r < 16; ++r) { pA0[r] = __builtin_amdgcn_exp2f(pA0[r]); pA1[r] = __builtin_amdgcn_exp2f(pA1[r]); }
  SWAIT(); SWRITEB(1); __syncthreads();
  for (int j = t0 + 1; j + 1 < t1; j += 2) {
    if (j + 2 < t1) SLOADB((j + 2) * 64); SBAR();
    sc_init(pB0, pB1, DQ(j), nsl2, m_reg, SIDE(j)); SBAR();
    qk_fin(pB0, pB1, K_lds + SHM_K, qr, r32, hi, cbase, pA0, pA1, l_reg, pa0, pa1, pa2, pa3);
    pv_exp(o, vb0, pa0, pa1, pa2, pa3, pB0, pB1);
    __syncthreads(); SWAIT(); SWRITEA(0); __syncthreads();
    if (j + 3 < t1) SLOADA((j + 3) * 64); SBAR();
    sc_init(pA0, pA1, DQ(j + 1), nsl2, m_reg, SIDE(j + 1)); SBAR();
    qk_fin(pA0, pA1, K_lds, qr, r32, hi, cbase, pB0, pB1, l_reg, pa0, pa1, pa2, pa3);
    pv_exp(o, vb0 + SHM_V, pa0, pa1, pa2, pa3, pA0, pA1);
    __syncthreads(); SWAIT(); SWRITEB(1); __syncthreads();
  }
  sc_init(pB0, pB1, DQ(t1 - 1), nsl2, m_reg, SIDE(t1 - 1)); SBAR();
  qk_fin(pB0, pB1, K_lds + SHM_K, qr, r32, hi, cbase, pA0, pA1, l_reg, pa0, pa1, pa2, pa3);
  pv_exp(o, vb0, pa0, pa1, pa2, pa3, pB0, pB1);
  fin_only(pB0, pB1, l_reg, pa0, pa1, pa2, pa3); SBAR();
  pv_d0(o, vb0 + SHM_V, pa0, pa1, pa2, pa3);
  int tide_ = threadIdx.x; asm volatile("" : "+v"(tide_)); const int lanee = tide_ & 63, r32e = lanee & 31, hie = lanee >> 5, wide = tide_ >> 6, wqe = wide & 3, mpe = wide >> 2;
  if (hie == 0) li_l[r32e] = l_reg; asm volatile("s_waitcnt lgkmcnt(0)" ::: "memory");
  float rli[16];
#pragma unroll
  for (int r = 0; r < 16; ++r) rli[r] = __builtin_amdgcn_rcpf(li_l[crow(r, hie)]);
  asm volatile("s_waitcnt vmcnt(0)" ::: "memory");
  __syncthreads();
  float* X = (float*)lds;
  if (mpe == 1) {
#pragma unroll
    for (int d0 = 0; d0 < 4; ++d0)
#pragma unroll
      for (int r = 0; r < 16; ++r) X[(wqe * 64 + d0 * 16 + r) * 64 + lanee] = o[d0][r] * rli[r] * lam;
  }
  __syncthreads();
  if (mpe == 0) {
    float g4[4];
#pragma unroll
    for (int d0 = 0; d0 < 4; ++d0) g4[d0] = gn[d0 * 32 + r32e] * 0.8f;
#pragma unroll
    for (int d0 = 0; d0 < 4; ++d0)
#pragma unroll
      for (int r = 0; r < 16; ++r) o[d0][r] = o[d0][r] * rli[r] - X[(wqe * 64 + d0 * 16 + r) * 64 + lanee];
    bf16* Ow = MIXIN + (size_t)(seq0 + q0 + wqe * 32) * DM + h * 128 + r32e;
#pragma unroll
    for (int r = 0; r < 16; ++r) {
      float ss = o[0][r] * o[0][r] + o[1][r] * o[1][r] + o[2][r] * o[2][r] + o[3][r] * o[3][r];
      ss += __shfl_xor(ss, 1); ss += __shfl_xor(ss, 2); ss += __shfl_xor(ss, 4); ss += __shfl_xor(ss, 8); ss += __shfl_xor(ss, 16);
      const float sc_ = 1.0f / sqrtf(ss * (1.0f / 128.0f) + EPS);
      const int orow = crow(r, hie);
#pragma unroll
      for (int d0 = 0; d0 < 4; ++d0) Ow[(size_t)orow * DM + d0 * 32] = (bf16)f2bf(o[d0][r] * sc_ * g4[d0]);
    }
  }
  __syncthreads();
#undef SLOADA
#undef SLOADB
#undef SWRITEA
#undef SWRITEB
#undef SWAIT
#undef RESC
#undef DQ
#undef SIDE
}
}

namespace gla {
#define LBAR() do { asm volatile("s_waitcnt lgkmcnt(0)" ::: "memory"); __builtin_amdgcn_s_barrier(); asm volatile("" ::: "memory"); } while (0)
constexpr int GS = 68;
constexpr int VS = 272;
constexpr int ST72 = 72;
constexpr int L_BD = 0, L_ATTF = 0, L_ATTB = 9216, L_V = 34816, L_SF = 52224, L_SB = 69632, L_QTF = 87040, L_QTB = 96256, L_KTF = 105472, L_KTB = 114688, L_RS = 123904;
typedef LAS const char* lcp;
typedef short v4i16_t __attribute__((ext_vector_type(4)));
__device__ __forceinline__ bf16x8 frag(lcp base, int row0, int k0, int lane) { return *(LAS const bf16x8*)(base + ((row0 + (lane & 31)) * ST72 + k0 + 8 * (lane >> 5)) * 2); }
__device__ __forceinline__ s16x4 tr4(lcp p) { return __builtin_bit_cast(s16x4, __builtin_amdgcn_ds_read_tr16_b64_v4i16((LAS v4i16_t*)p)); }
__device__ __forceinline__ bf16x8 trfrag(lcp base, int rs, int k0, int n0, int lane) {
  const int g = lane >> 4, r = (lane & 15) >> 2, c = lane & 3;
  lcp p = base + (k0 + 8 * (g >> 1) + r) * rs + (n0 + 16 * (g & 1) + 4 * c) * 2;
  const s16x4 lo = tr4(p), hi = tr4(p + 4 * rs);
  return (bf16x8){lo[0], lo[1], lo[2], lo[3], hi[0], hi[1], hi[2], hi[3]};
}
__device__ __forceinline__ float logsig(float z) { return fminf(z, 0.f) - __logf(1.0f + __expf(-__builtin_fabsf(z))); }
struct GPre { v4u kk, qq; v4u vv[4]; v4u sfv[4], sbv[4]; bf16x8 lr0, lr1, wb; float bias; unsigned short grv[16]; };
template <bool G3>
__device__ __forceinline__ void load_pre(GPre& R, const bf16* __restrict__ P, const Args& a, const bf16* __restrict__ WGT, const bf16* __restrict__ STATE, int n, int h) {
  int tid_ = threadIdx.x; asm volatile("" : "+v"(tid_)); const int tid = tid_, lane = tid & 63, wid = __builtin_amdgcn_readfirstlane(tid >> 6), r32 = lane & 31, hi = lane >> 5, row0 = n * 64, s = tid >> 3, dg = tid & 7;
  R.kk = *(const v4u*)(P + (size_t)(row0 + s) * LDP + C_GK + h * 64 + dg * 8);
  if (G3) { R.qq = *(const v4u*)(P + (size_t)(row0 + s) * LDP + C_GQ + h * 64 + dg * 8);
    const int ct_ = wid >> 2, et_ = wid & 3;
#pragma unroll
    for (int r = 0; r < 16; ++r) R.grv[r] = P[(size_t)(row0 + 32 * ct_ + crow(r, hi)) * LDP + C_GR + h * 128 + 32 * et_ + r32]; }
  if (wid < 4) { const int dir = wid >> 1, dt = wid & 1, c = h * 64 + 32 * dt + r32;
    R.wb = *(const bf16x8*)(WGT + ((size_t)dir * 256 + c) * 16 + 8 * hi); R.bias = (dir ? a.in[14] : a.in[12])[c];
    R.lr0 = *(const bf16x8*)(P + (size_t)(row0 + r32) * LDP + (dir ? C_LRB : C_LRF) + 8 * hi); R.lr1 = *(const bf16x8*)(P + (size_t)(row0 + 32 + r32) * LDP + (dir ? C_LRB : C_LRF) + 8 * hi);
  } else { const int t = tid - 256, s2 = t >> 2, part = t & 3;
    { const v4u* src = (const v4u*)(P + (size_t)(row0 + s2) * LDP + C_GV + h * 128 + part * 32); R.vv[0] = src[0]; R.vv[1] = src[1]; R.vv[2] = src[2]; R.vv[3] = src[3]; }
    if (G3) { const v4u* sf = (const v4u*)(STATE + ((size_t)(0 * NCHUNK + n) * 4 + h) * 8192 + s2 * 128 + part * 32); const v4u* sb = (const v4u*)(STATE + ((size_t)(1 * NCHUNK + n) * 4 + h) * 8192 + s2 * 128 + part * 32);
#pragma unroll
      for (int i = 0; i < 4; ++i) { R.sfv[i] = sf[i]; R.sbv[i] = sb[i]; } }
  }
}
template <bool WITH_S>
__device__ __forceinline__ void prep(const GPre& R, int n, int h, LAS char* lds) {
  int tid_ = threadIdx.x; asm volatile("" : "+v"(tid_)); const int tid = tid_, lane = tid & 63, wid = __builtin_amdgcn_readfirstlane(tid >> 6), r32 = lane & 31, hi = lane >> 5, row0 = n * 64;
  if (wid < 4) {
    const int dir = wid >> 1, dt = wid & 1;
    const bf16x8 bfr = R.wb;
    const float bias = R.bias;
    float g[32];
#pragma unroll
    for (int st = 0; st < 2; ++st) { const bf16x8 afr = st ? R.lr1 : R.lr0;
      f32x16 z = {}; z = __builtin_amdgcn_mfma_f32_32x32x16_bf16(afr, bfr, z, 0, 0, 0);
#pragma unroll
      for (int r = 0; r < 16; ++r) g[16 * st + r] = logsig(z[r] + bias) * 0.0625f; }
    float T[8], Tp[8];
    if (dir == 0) {
#pragma unroll
      for (int i = 0; i < 8; ++i) { g[4 * i + 1] += g[4 * i]; g[4 * i + 2] += g[4 * i + 1]; g[4 * i + 3] += g[4 * i + 2]; T[i] = g[4 * i + 3]; }
    } else {
#pragma unroll
      for (int i = 0; i < 8; ++i) { g[4 * i + 2] += g[4 * i + 3]; g[4 * i + 1] += g[4 * i + 2]; g[4 * i] += g[4 * i + 1]; T[i] = g[4 * i]; }
    }
#pragma unroll
    for (int i = 0; i < 8; ++i) Tp[i] = __shfl_xor(T[i], 32);
    if (dir == 0) { float run = 0.f;
#pragma unroll
      for (int i = 0; i < 8; ++i) { const float E = run + (hi ? Tp[i] : 0.f); run += T[i] + Tp[i];
#pragma unroll
        for (int q = 0; q < 4; ++q) g[4 * i + q] += E; }
    } else { float run = 0.f;
#pragma unroll
      for (int i = 7; i >= 0; --i) { const float E = run + (hi ? 0.f : Tp[i]); run += T[i] + Tp[i];
#pragma unroll
        for (int q = 0; q < 4; ++q) g[4 * i + q] += E; }
    }
    LAS float* B = (LAS float*)(lds + L_BD) + dir * 64 * GS + 32 * dt + r32;
#pragma unroll
    for (int i = 0; i < 8; ++i)
#pragma unroll
      for (int q = 0; q < 4; ++q) { const int s = 32 * (i >> 2) + q + 8 * (i & 3) + 4 * hi; B[s * GS] = g[4 * i + q]; }
  } else {
    const int t = tid - 256, s = t >> 2, part = t & 3;
    { LAS v4u* dst = (LAS v4u*)(lds + L_V + s * VS + part * 64); dst[0] = R.vv[0]; dst[1] = R.vv[1]; dst[2] = R.vv[2]; dst[3] = R.vv[3]; }
    if (WITH_S) { LAS v4u* df = (LAS v4u*)(lds + L_SF + s * VS + part * 64); LAS v4u* db = (LAS v4u*)(lds + L_SB + s * VS + part * 64);
#pragma unroll
      for (int i = 0; i < 4; ++i) { df[i] = R.sfv[i]; db[i] = R.sbv[i]; } }
  }
  LBAR();
}
__device__ __forceinline__ void g1_unit(const GPre& R, bf16* __restrict__ STATE, float* __restrict__ DEC, int n, int h, LAS char* lds) {
  int tid_ = threadIdx.x; asm volatile("" : "+v"(tid_)); const int tid = tid_, lane = tid & 63, wid = __builtin_amdgcn_readfirstlane(tid >> 6), s = tid >> 3, dg = tid & 7, row0 = n * 64;
  const v4u kk = R.kk;
  prep<false>(R, n, h, lds);
  { const LAS float* Bf = (const LAS float*)(lds + L_BD); const LAS float* Bb = Bf + 64 * GS;
    float kef[8], keb[8];
#pragma unroll
    for (int j = 0; j < 8; ++j) { const int d = dg * 8 + j; const float kv = (j & 1) ? bfhi(kk[j >> 1]) : bflo(kk[j >> 1]);
      const float bl = Bf[63 * GS + d], b0 = Bb[d];
      kef[j] = kv * __expf(bl - Bf[s * GS + d]); keb[j] = kv * __expf(b0 - Bb[s * GS + d]);
      if (s == 0) { DEC[((size_t)(0 * NCHUNK + n) * 4 + h) * 64 + d] = __expf(bl); DEC[((size_t)(1 * NCHUNK + n) * 4 + h) * 64 + d] = __expf(b0); } }
    v4u w;
    w.x = pk2(kef[0], kef[1]); w.y = pk2(kef[2], kef[3]); w.z = pk2(kef[4], kef[5]); w.w = pk2(kef[6], kef[7]); *(LAS v4u*)(lds + L_KTF + (s * ST72 + dg * 8) * 2) = w;
    w.x = pk2(keb[0], keb[1]); w.y = pk2(keb[2], keb[3]); w.z = pk2(keb[4], keb[5]); w.w = pk2(keb[6], keb[7]); *(LAS v4u*)(lds + L_KTB + (s * ST72 + dg * 8) * 2) = w; }
  LBAR();
  const int dt = wid >> 2, et = wid & 3, r32 = lane & 31, hi = lane >> 5;
#pragma unroll
  for (int dir = 0; dir < 2; ++dir) { f32x16 acc = {};
#pragma unroll
    for (int ks = 0; ks < 4; ++ks) acc = __builtin_amdgcn_mfma_f32_32x32x16_bf16(trfrag(lds + (dir ? L_KTB : L_KTF), ST72 * 2, 16 * ks, 32 * dt, lane), trfrag(lds + L_V, VS, 16 * ks, 32 * et, lane), acc, 0, 0, 0);
    bf16* So = STATE + ((size_t)(dir * NCHUNK + n) * 4 + h) * 8192;
#pragma unroll
    for (int r = 0; r < 16; ++r) So[(32 * dt + crow(r, hi)) * 128 + 32 * et + r32] = (bf16)f2bf(acc[r]); }
  LBAR();
}
__device__ __forceinline__ void g3_unit(const GPre& R, const float* __restrict__ gng, bf16* __restrict__ MIXIN, int n, int h, LAS char* lds) {
  int tid_ = threadIdx.x; asm volatile("" : "+v"(tid_)); const int tid = tid_, lane = tid & 63, wid = __builtin_amdgcn_readfirstlane(tid >> 6), s = tid >> 3, dg = tid & 7, row0 = n * 64, r32 = lane & 31, hi = lane >> 5;
  const v4u kk = R.kk, qq = R.qq;
  prep<true>(R, n, h, lds);
  { const LAS float* Bf = (const LAS float*)(lds + L_BD); const LAS float* Bb = Bf + 64 * GS;
    float qf[8], kf[8], qb[8], kb[8];
#pragma unroll
    for (int j = 0; j < 8; ++j) { const int d = dg * 8 + j; const float kv = (j & 1) ? bfhi(kk[j >> 1]) : bflo(kk[j >> 1]); const float qv = ((j & 1) ? bfhi(qq[j >> 1]) : bflo(qq[j >> 1])) * 0.125f;
      const float bf_ = Bf[s * GS + d], bb_ = Bb[s * GS + d];
      qf[j] = qv * __expf(bf_); kf[j] = kv * __expf(-bf_); qb[j] = qv * __expf(bb_); kb[j] = kv * __expf(-bb_); }
    v4u w;
    w.x = pk2(qf[0], qf[1]); w.y = pk2(qf[2], qf[3]); w.z = pk2(qf[4], qf[5]); w.w = pk2(qf[6], qf[7]); *(LAS v4u*)(lds + L_QTF + (s * ST72 + dg * 8) * 2) = w;
    w.x = pk2(qb[0], qb[1]); w.y = pk2(qb[2], qb[3]); w.z = pk2(qb[4], qb[5]); w.w = pk2(qb[6], qb[7]); *(LAS v4u*)(lds + L_QTB + (s * ST72 + dg * 8) * 2) = w;
    w.x = pk2(kf[0], kf[1]); w.y = pk2(kf[2], kf[3]); w.z = pk2(kf[4], kf[5]); w.w = pk2(kf[6], kf[7]); *(LAS v4u*)(lds + L_KTF + (s * ST72 + dg * 8) * 2) = w;
    w.x = pk2(kb[0], kb[1]); w.y = pk2(kb[2], kb[3]); w.z = pk2(kb[4], kb[5]); w.w = pk2(kb[6], kb[7]); *(LAS v4u*)(lds + L_KTB + (s * ST72 + dg * 8) * 2) = w; }
  LBAR();
  { const int dir = wid >> 2, ct = (wid >> 1) & 1, st = wid & 1; f32x16 acc = {};
    lcp Q = lds + (dir ? L_QTB : L_QTF); lcp K = lds + (dir ? L_KTB : L_KTF);
#pragma unroll
    for (int ks = 0; ks < 4; ++ks) acc = __builtin_amdgcn_mfma_f32_32x32x16_bf16(frag(Q, 32 * ct, 16 * ks, lane), frag(K, 32 * st, 16 * ks, lane), acc, 0, 0, 0);
    LAS bf16* ATT = (LAS bf16*)(lds + (dir ? L_ATTB : L_ATTF));
#pragma unroll
    for (int r = 0; r < 16; ++r) { const int c = 32 * ct + crow(r, hi), s_ = 32 * st + r32; const bool keep = dir ? (s_ > c) : (s_ <= c);
      ATT[c * ST72 + s_] = (bf16)f2bf(keep ? acc[r] : 0.f); } }
  LBAR();
  { const int ct = wid >> 2, et = wid & 3; f32x16 acc = {};
#pragma unroll
    for (int dir = 0; dir < 2; ++dir) { lcp ATT = lds + (dir ? L_ATTB : L_ATTF); lcp Q = lds + (dir ? L_QTB : L_QTF); lcp S = lds + (dir ? L_SB : L_SF);
#pragma unroll
      for (int ks = 0; ks < 4; ++ks) { acc = __builtin_amdgcn_mfma_f32_32x32x16_bf16(frag(ATT, 32 * ct, 16 * ks, lane), trfrag(lds + L_V, VS, 16 * ks, 32 * et, lane), acc, 0, 0, 0);
                                       acc = __builtin_amdgcn_mfma_f32_32x32x16_bf16(frag(Q, 32 * ct, 16 * ks, lane), trfrag(S, VS, 16 * ks, 32 * et, lane), acc, 0, 0, 0); } }
    LAS float* RS = (LAS float*)(lds + L_RS);
    float ssr[16];
#pragma unroll
    for (int r = 0; r < 16; ++r) { float ss = acc[r] * acc[r]; ss += __shfl_xor(ss, 1); ss += __shfl_xor(ss, 2); ss += __shfl_xor(ss, 4); ss += __shfl_xor(ss, 8); ss += __shfl_xor(ss, 16); ssr[r] = ss; }
    if (r32 == 0) {
#pragma unroll
      for (int r = 0; r < 16; ++r) RS[wid * 32 + crow(r, hi)] = ssr[r]; }
    LBAR();
    const int e = 32 * et + r32; const float g = gng[e];
#pragma unroll
    for (int r = 0; r < 16; ++r) { const int cl = crow(r, hi), c = 32 * ct + cl;
      const float tot = RS[(ct * 4 + 0) * 32 + cl] + RS[(ct * 4 + 1) * 32 + cl] + RS[(ct * 4 + 2) * 32 + cl] + RS[(ct * 4 + 3) * 32 + cl];
      const float sc_ = 1.0f / sqrtf(tot * (1.0f / 128.0f) + EPS);
      const float gr = bf2f(R.grv[r]);
      const float sl = gr * __builtin_amdgcn_rcpf(1.0f + __expf(-gr));
      MIXIN[(size_t)(row0 + c) * DM + 512 + h * 128 + e] = (bf16)f2bf(acc[r] * sc_ * g * sl); }
  }
  LBAR();
}
}

#define XB_TMO      128
#define XB_XCNT(j)  (256  + 64 * (j))
#define XB_XSUB(j)  (1280 + 64 * (j))
#define XB_XGEN(j)  (2304 + 64 * (j))
#define XB_TOP      3328
#define XB_TOPGEN   3392
#define XCD_BAR_WORDS 3456
#define XB_SPIN_CAP (1u << 18)

__device__ __forceinline__ unsigned xb_ld(unsigned* p)              { return __hip_atomic_load(p, __ATOMIC_RELAXED, __HIP_MEMORY_SCOPE_AGENT); }
__device__ __forceinline__ unsigned xb_add(unsigned* p, unsigned v) { return __hip_atomic_fetch_add(p, v, __ATOMIC_RELAXED, __HIP_MEMORY_SCOPE_AGENT); }
__device__ __forceinline__ unsigned xb_xcc_id() { return (unsigned)__builtin_amdgcn_s_getreg((3 << 11) | 20) & 0xFu; }
#define XB_SPIN(cond, bar) do { unsigned _sp = 0; while (cond) { __builtin_amdgcn_s_sleep(1); \
    if ((++_sp & 255u) == 0u) { if (xb_ld(&(bar)[XB_TMO])) break; if (_sp > XB_SPIN_CAP) { atomicAdd(&(bar)[XB_TMO], 1u); break; } } } } while (0)

struct XcdBarrier {
    unsigned* bar; unsigned x;
    volatile LAS unsigned* st;
};

__device__ __forceinline__ XcdBarrier xcd_barrier_post(unsigned* bar, volatile LAS unsigned* st) {
    XcdBarrier b; b.bar = bar; b.x = xb_xcc_id(); b.st = st;
    if (threadIdx.x == 0) (void)xb_add(&bar[XB_XCNT(b.x)], 1u);
    return b;
}
__device__ __forceinline__ void xcd_barrier_complete(unsigned* bar, unsigned x, unsigned& nloc, unsigned& nx) {
    const unsigned G = gridDim.x * gridDim.y * gridDim.z;
    unsigned sum, cnt, mine, sp = 0u;
    for (;;) {
        sum = 0u; cnt = 0u; mine = 0u;
#pragma unroll
        for (unsigned j = 0; j < 16; ++j) { const unsigned c = xb_ld(&bar[XB_XCNT(j)]); sum += c; cnt += (c > 0u) ? 1u : 0u; mine = (j == x) ? c : mine; }
        if (sum == G) break;
        __builtin_amdgcn_s_sleep(1);
        if ((++sp & 255u) == 0u) { if (xb_ld(&bar[XB_TMO])) break; if (sp > XB_SPIN_CAP) { atomicAdd(&bar[XB_TMO], 1u); break; } }
    }
    nloc = mine > 0u ? mine : 1u; nx = cnt > 0u ? cnt : 1u;
}

__device__ __forceinline__ void xcd_barrier(const XcdBarrier& b) {
    asm volatile("s_waitcnt vmcnt(0)" ::: "memory");
    __syncthreads();
    if (threadIdx.x == 0) {
        unsigned* bar = b.bar;
        __builtin_amdgcn_s_waitcnt(0);
        unsigned nloc = b.st[0], nx = b.st[1];
        if (nloc == 0u) { xcd_barrier_complete(bar, b.x, nloc, nx); b.st[0] = nloc; b.st[1] = nx; }
        const unsigned old = xb_add(&bar[XB_XSUB(b.x)], 1u);
        const unsigned gen = old / nloc;
        if (old + 1u == (gen + 1u) * nloc) {
            __builtin_amdgcn_fence(__ATOMIC_RELEASE, "agent");
            asm volatile("s_waitcnt vmcnt(0)" ::: "memory");
            const unsigned og = xb_add(&bar[XB_TOP], 1u);
            const unsigned tg = og / nx;
            if (og + 1u == (tg + 1u) * nx) xb_add(&bar[XB_TOPGEN], 1u);
            else XB_SPIN(xb_ld(&bar[XB_TOPGEN]) == tg, bar);
            __builtin_amdgcn_fence(__ATOMIC_ACQUIRE, "agent");
            xb_add(&bar[XB_XGEN(b.x)], 1u);
            asm volatile("s_waitcnt vmcnt(0)" ::: "memory");
        } else {
            XB_SPIN(xb_ld(&bar[XB_XGEN(b.x)]) == gen, bar);
            __builtin_amdgcn_fence(__ATOMIC_ACQUIRE, "agent");
            asm volatile("s_waitcnt vmcnt(0)" ::: "memory");
        }
    }
    __syncthreads();
}

__global__ void __launch_bounds__(NWAVES * 64, 2) hymba_fwd(Args args) {
    extern __shared__ __attribute__((aligned(16))) unsigned char lds[];
    cg::grid_group grid = cg::this_grid();
    LAS unsigned char* ldsl = (LAS unsigned char*)lds;
    volatile LAS unsigned* MISC = (volatile LAS unsigned*)(ldsl + MISC_OFF);
    const int tid = threadIdx.x, lane = tid & 63, wave = __builtin_amdgcn_readfirstlane(tid >> 6);
    const int G = gridDim.x, bid = blockIdx.x;
    const int gw = bid * NWAVES + wave, NGW = G * NWAVES;
    unsigned char* ws = args.ws;
    unsigned* ctl = (unsigned*)(ws + WS_CTL);
    bf16* Wup_t = (bf16*)(ws + WS_WUP); bf16* Wdown_t = (bf16*)(ws + WS_WDOWN); bf16* Win_t = (bf16*)(ws + WS_WIN); bf16* Wout_t = (bf16*)(ws + WS_WOUT);
    bf16* Wgate_t = (bf16*)(ws + WS_WGATE); bf16* Wproj_t = (bf16*)(ws + WS_WPROJ);
    bf16* H = (bf16*)(ws + WS_H); bf16* PROJ = (bf16*)(ws + WS_PROJ); bf16* MIX = (bf16*)(ws + WS_MIX); bf16* ACT = (bf16*)(ws + WS_ACT);
    bf16* X2B = (bf16*)(ws + WS_X2B); bf16* PB = (bf16*)(ws + WS_PB); bf16* GOUT = (bf16*)(ws + WS_GOUT); bf16* EOUT = (bf16*)(ws + WS_EOUT);
    float* DEC = (float*)(ws + WS_DEC); bf16* STATE = (bf16*)args.out;
    bf16* WGT = (bf16*)(ws + WS_WGT);
    float* OUT = args.out; bf16* X1B = (bf16*)args.out;
    if (tid < 32) MISC[tid] = 0u;
    __syncthreads();
    XcdBarrier xbar = xcd_barrier_post(ctl + CW_BAR, MISC + 8);
    if (gridDim.x > 65535u) grid.sync();

    {
        LAS float* scr = (LAS float*)(ldsl + wave * 16384);
        constexpr int I_IN = 16 * 97, I_OUT = 16 * 32, I_UP = 16 * 256, I_DOWN = 64 * 32, NITEMS = I_IN + I_OUT + I_UP + I_DOWN;
        for (int it = gw; it < NITEMS; it += NGW) {
            int r = it;
            if (r < I_IN) { const int kb = r / 97, nb = r % 97; transpose_item(args.in[5], 1024, 3104, Win_t, 64 * kb, 32 * nb, 32 * nb, scr, lane); continue; } r -= I_IN;
            if (r < I_OUT) { const int kb = r / 32, nb = r % 32; transpose_item(args.in[16], 1024, 1024, Wout_t, 64 * kb, 32 * nb, 32 * nb, scr, lane); continue; } r -= I_OUT;
            if (r < I_UP) { const int kb = r / 256, nb = r % 256; const int n0d = 32 * nb, pn = n0d >> 8, j = n0d & 255; const int n0s = (j < 128) ? (128 * pn + j) : (4096 + 128 * pn + (j - 128));
                transpose_item(args.in[19], 1024, 8192, Wup_t, 64 * kb, n0s, n0d, scr, lane); continue; } r -= I_UP;
            { const int kb = r / 32, nb = r % 32; transpose_item(args.in[22], 4096, 1024, Wdown_t, 64 * kb, 32 * nb, 32 * nb, scr, lane); }
        }
        { v4u z = {0u, 0u, 0u, 0u}; v4u* zp = (v4u*)(Win_t + (size_t)3104 * 1024); const int nz = 224 * 1024 * 2 / 16;
          for (int i = bid * 512 + tid; i < nz; i += G * 512) zp[i] = z; }
        { f32x4 gv[4];
#pragma unroll
          for (int j = 0; j < 4; ++j) gv[j] = *(const f32x4*)(args.in[4] + 4 * lane + 256 * j);
          for (int m = gw; m < MROWS; m += NGW) { const f32x4* xr = (const f32x4*)xrow_ptr(args, m) + lane; f32x4 v[4]; float s = 0.f;
#pragma unroll
            for (int j = 0; j < 4; ++j) { v[j] = __builtin_nontemporal_load(xr + 64 * j); s += (v[j].x * v[j].x + v[j].y * v[j].y) + (v[j].z * v[j].z + v[j].w * v[j].w); }
            const float rs = 1.0f / sqrtf(wave_sum(s) * (1.0f / DM) + EPS);
            v2u* o8 = (v2u*)(H + (size_t)m * DM) + lane;
#pragma unroll
            for (int j = 0; j < 4; ++j) { v2u w; w.x = pk2(v[j].x * rs * gv[j].x, v[j].y * rs * gv[j].y); w.y = pk2(v[j].z * rs * gv[j].z, v[j].w * rs * gv[j].w); o8[64 * j] = w; } } }
        for (int i = bid * 512 + tid; i < 8192; i += G * 512) { const int dir = i >> 12, c = (i >> 4) & 255, r = i & 15; WGT[i] = (bf16)f2bf((dir ? args.in[13] : args.in[11])[r * 256 + c]); }
        if (bid == 0 && wave == 0) { const float a1 = args.in[6][lane] * args.in[7][lane], a2 = args.in[8][lane] * args.in[9][lane];
            const float s1 = wave_sum(a1), s2 = wave_sum(a2); if (lane == 0) ((float*)ctl)[CW_LAM] = __expf(s1) - __expf(s2) + 0.2f; }
    }
    xcd_barrier(xbar);
    { pg8::Gemm g{H, Win_t, MROWS, LDP, 1024}; pg8::StaticOrder S; S.init(MROWS, LDP, G, bid); pg8::EpiBf16S E{PROJ, LDP, 2, 0.125f * 1.4426950408889634f};
      pg8::gemm_phase<pg8::EpiBf16S, pg8::StaticOrder, true, true>(ldsl, g, S, E); }
    xcd_barrier(xbar);
    {
      const int rpw = (MROWS + NGW - 1) / NGW; int m0 = gw * rpw, m1 = m0 + rpw; if (m1 > MROWS) m1 = MROWS;
      float mx = 0.f; int cs = -1;
      for (int m = m0; m < m1; ++m) { const int sq = m < NPROMPT ? (m >> 11) : 16;
        if (sq != cs) { if (cs >= 0 && (lane & 7) == 0) atomicMax(ctl + CW_NORM + cs * 16 + 8 + (lane >> 3), __float_as_uint(mx)); mx = 0.f; cs = sq; }
        const v4u a0 = *(const v4u*)(PROJ + (size_t)m * LDP + C_DAK + lane * 8);
        float ss = 0.f;
#pragma unroll
        for (int i = 0; i < 4; ++i) { const float x0 = bflo(a0[i]), x1 = bfhi(a0[i]); ss += x0 * x0 + x1 * x1; }
        ss += __shfl_xor(ss, 1); ss += __shfl_xor(ss, 2); ss += __shfl_xor(ss, 4); mx = fmaxf(mx, ss); }
      if (cs >= 0 && (lane & 7) == 0) atomicMax(ctl + CW_NORM + cs * 16 + 8 + (lane >> 3), __float_as_uint(mx)); }
    { gla::GPre cur, nxt; int u = bid;
      if (u < NCHUNK * 4) gla::load_pre<false>(cur, PROJ, args, WGT, STATE, u >> 2, u & 3);
      for (; u < NCHUNK * 4; u += G) { const int un = u + G;
        if (un < NCHUNK * 4) gla::load_pre<false>(nxt, PROJ, args, WGT, STATE, un >> 2, un & 3);
        gla::g1_unit(cur, STATE, DEC, u >> 2, u & 3, (LAS char*)ldsl); cur = nxt; } }
    xcd_barrier(xbar);
    {
        constexpr int NI = 2 * 68 * 32;
        for (int i = gw; i < NI; i += NGW) {
            const int sub = i & 31, t = i >> 5, dir = t & 1, sh = t >> 1;
            int n0, nc, h;
            if (sh < 4) { n0 = 512; nc = 256; h = sh; } else { const int v = sh - 4; n0 = 32 * (v >> 2); nc = 32; h = v & 3; }
            const size_t eoff = (size_t)sub * 256 + lane * 4; const int d = sub * 2 + (lane >> 5);
            f32x4 st = {0.f, 0.f, 0.f, 0.f};
            for (int k = 0; k < nc; k += 8) {
                v2u kv[8]; float dc[8];
#pragma unroll
                for (int q = 0; q < 8; ++q) { const int n = dir ? (n0 + nc - 1 - (k + q)) : (n0 + k + q); const size_t ch = (size_t)(dir * NCHUNK + n) * 4 + h;
                    kv[q] = *(const v2u*)(STATE + ch * 8192 + eoff); dc[q] = DEC[ch * 64 + d]; }
#pragma unroll
                for (int q = 0; q < 8; ++q) { const int n = dir ? (n0 + nc - 1 - (k + q)) : (n0 + k + q); const size_t ch = (size_t)(dir * NCHUNK + n) * 4 + h;
                    v2u w; w.x = pk2(st.x, st.y); w.y = pk2(st.z, st.w); *(v2u*)(STATE + ch * 8192 + eoff) = w;
                    const f32x4 kvf = {bflo(kv[q].x), bfhi(kv[q].x), bflo(kv[q].y), bfhi(kv[q].y)}; st = st * dc[q] + kvf; }
            }
        }
        __syncthreads();
        const float lam = ((const float*)ctl)[CW_LAM];
        constexpr int NU = 512 + 1024;
        for (;;) {
            if (tid == 0) MISC[0] = atomicAdd(ctl + CW_QCTR, 1u);
            __syncthreads();
            const int u = (int)MISC[0];
            __syncthreads();
            if (u >= NU) break;
            int seq0, h, q0, nt, sq;
            if (u < 512) { h = 3 - (u >> 7); q0 = (u & 127) * 128; seq0 = NPROMPT; nt = SS / 64; sq = 16; }
            else { const int v = u - 512; h = 3 - (v >> 8); sq = (v >> 4) & 15; q0 = (v & 15) * 128; seq0 = sq * SP; nt = SP / 64; }
            const float slope = (h == 0) ? 0.25f : (h == 1) ? 0.0625f : (h == 2) ? 0.015625f : 0.00390625f;
            const float kmax0 = sqrtf(__uint_as_float(__hip_atomic_load(ctl + CW_NORM + sq * 16 + 8 + h * 2 + 0, __ATOMIC_RELAXED, __HIP_MEMORY_SCOPE_AGENT)));
            const float kmax1 = sqrtf(__uint_as_float(__hip_atomic_load(ctl + CW_NORM + sq * 16 + 8 + h * 2 + 1, __ATOMIC_RELAXED, __HIP_MEMORY_SCOPE_AGENT)));
            da::attn_unit(PROJ, H, args.in[10], seq0, h, q0, nt, kmax0, kmax1, slope, lam, (char*)lds);
        }
    }
    xcd_barrier(xbar);
    { gla::GPre cur, nxt; int u = bid;
      if (u < NCHUNK * 4) gla::load_pre<true>(cur, PROJ, args, WGT, STATE, u >> 2, u & 3);
      for (; u < NCHUNK * 4; u += G) { const int un = u + G;
        if (un < NCHUNK * 4) gla::load_pre<true>(nxt, PROJ, args, WGT, STATE, un >> 2, un & 3);
        gla::g3_unit(cur, args.in[15], H, u >> 2, u & 3, (LAS char*)ldsl); cur = nxt; } }
    xcd_barrier(xbar);
    { pg8::Gemm g{H, Wout_t, MROWS, 1024, 1024}; pg8::StaticOrder S; S.init(MROWS, 1024, G, bid); pg8::EpiBf16S E{MIX, 1024, 0, 1.f};
      pg8::gemm_phase<pg8::EpiBf16S, pg8::StaticOrder, true, true>(ldsl, g, S, E); }
    xcd_barrier(xbar);
    {
      int tidf_ = threadIdx.x; asm volatile("" : "+v"(tidf_)); const int tid = tidf_, lane = tid & 63, wave = __builtin_amdgcn_readfirstlane(tid >> 6), gw = bid * NWAVES + wave; (void)tid; (void)wave;
      f32x4 g1[4], g2[4];
#pragma unroll
      for (int j = 0; j < 4; ++j) { g1[j] = *(const f32x4*)(args.in[17] + 4 * lane + 256 * j); g2[j] = *(const f32x4*)(args.in[18] + 4 * lane + 256 * j); }
      for (int m = gw; m < MROWS; m += NGW) { const f32x4* xr = (const f32x4*)xrow_ptr(args, m) + lane; const v2u* mr = (const v2u*)(MIX + (size_t)m * DM) + lane;
        f32x4 v[4], mx[4]; float s = 0.f;
#pragma unroll
        for (int j = 0; j < 4; ++j) { v[j] = __builtin_nontemporal_load(xr + 64 * j); const v2u w = __builtin_nontemporal_load(mr + 64 * j); mx[j] = (f32x4){bflo(w.x), bfhi(w.x), bflo(w.y), bfhi(w.y)};
          s += (mx[j].x * mx[j].x + mx[j].y * mx[j].y) + (mx[j].z * mx[j].z + mx[j].w * mx[j].w); }
        const float rs = 1.0f / sqrtf(wave_sum(s) * (1.0f / DM) + EPS); float s2 = 0.f;
        v2u* orow = (v2u*)(X1B + (size_t)m * DM) + lane;
#pragma unroll
        for (int j = 0; j < 4; ++j) { v[j] = v[j] + mx[j] * rs * g1[j]; { v2u w; w.x = pk2(v[j].x, v[j].y); w.y = pk2(v[j].z, v[j].w); __builtin_nontemporal_store(w, orow + 64 * j); } s2 += (v[j].x * v[j].x + v[j].y * v[j].y) + (v[j].z * v[j].z + v[j].w * v[j].w); }
        const float rs2 = 1.0f / sqrtf(wave_sum(s2) * (1.0f / DM) + EPS);
        v2u* o8 = (v2u*)(H + (size_t)m * DM) + lane;
        const int sm = m & 127; int crowi = -1;
        if (sm >= 126) crowi = 4 * (((m >> 7) + 1) % NGRP) + (sm - 126); else if (sm <= 1) crowi = 4 * (m >> 7) + 2 + sm;
        v2u* c8 = (v2u*)(H + (size_t)(MROWS + (crowi < 0 ? 0 : crowi)) * DM) + lane;
#pragma unroll
        for (int j = 0; j < 4; ++j) { v2u w; w.x = pk2(v[j].x * rs2 * g2[j].x, v[j].y * rs2 * g2[j].y); w.y = pk2(v[j].z * rs2 * g2[j].z, v[j].w * rs2 * g2[j].w); o8[64 * j] = w; if (crowi >= 0) c8[64 * j] = w; } } }
    xcd_barrier(xbar);
    { pg8::Gemm g{H, Wup_t, MROWS + NFIXROWS, 8192, 1024}; pg8::StaticOrder S; S.init(MROWS + NFIXROWS, 8192, G, bid); pg8::EpiConvGelu E{ACT, args.in[20], args.in[21], NMAINT, MROWS};
      pg8::gemm_phase<pg8::EpiConvGelu, pg8::StaticOrder, true, true, true>(ldsl, g, S, E); }
    xcd_barrier(xbar);
    { pg8::Gemm g{ACT, Wdown_t, MROWS, 1024, 4096}; pg8::StaticOrder S; S.init(MROWS, 1024, G, bid); pg8::EpiBf16S E{H, 1024, 0, 1.f};
      pg8::gemm_phase<pg8::EpiBf16S, pg8::StaticOrder, true, true>(ldsl, g, S, E); }
    xcd_barrier(xbar);
    {
      int tidf_ = threadIdx.x; asm volatile("" : "+v"(tidf_)); const int tid = tidf_, lane = tid & 63, wave = __builtin_amdgcn_readfirstlane(tid >> 6), gw = bid * NWAVES + wave; (void)tid; (void)wave;
        LAS float* scr = (LAS float*)(ldsl + wave * 16384);
        constexpr int I_G = 16 * 32, I_P = 4 * 32;
        for (int it = gw; it < I_G + I_P; it += NGW) {
            if (it < I_G) { const int kb = it / 32, nb = it % 32; transpose_item(args.in[24], 1024, 1024, Wgate_t, 64 * kb, 32 * nb, 32 * nb, scr, lane); }
            else { const int r = it - I_G; const int kb = r / 32, nb = r % 32; transpose_item(args.in[26], 256, 1024, Wproj_t, 64 * kb, 32 * nb, 32 * nb, scr, lane); }
        }
        f32x4 g1[4];
#pragma unroll
        for (int j = 0; j < 4; ++j) g1[j] = *(const f32x4*)(args.in[23] + 4 * lane + 256 * j);
        for (int m = gw; m < MROWS; m += NGW) { const v2u* xr = (const v2u*)(X1B + (size_t)m * DM) + lane; const v2u* mr = (const v2u*)(H + (size_t)m * DM) + lane;
            f32x4 v[4], mx[4]; float s = 0.f;
#pragma unroll
            for (int j = 0; j < 4; ++j) { { const v2u wx = __builtin_nontemporal_load(xr + 64 * j); v[j] = (f32x4){bflo(wx.x), bfhi(wx.x), bflo(wx.y), bfhi(wx.y)}; } const v2u w = __builtin_nontemporal_load(mr + 64 * j); mx[j] = (f32x4){bflo(w.x), bfhi(w.x), bflo(w.y), bfhi(w.y)};
              s += (mx[j].x * mx[j].x + mx[j].y * mx[j].y) + (mx[j].z * mx[j].z + mx[j].w * mx[j].w); }
            const float rs = 1.0f / sqrtf(wave_sum(s) * (1.0f / DM) + EPS);
            v2u* o8 = (v2u*)(X2B + (size_t)m * DM) + lane;
#pragma unroll
            for (int j = 0; j < 4; ++j) { v[j] = v[j] + mx[j] * rs * g1[j]; v2u w; w.x = pk2(v[j].x, v[j].y); w.y = pk2(v[j].z, v[j].w); o8[64 * j] = w; }
            const f32x4 pv = __builtin_nontemporal_load((const f32x4*)prow_ptr(args, m) + lane); v2u w; w.x = pk2(pv.x, pv.y); w.y = pk2(pv.z, pv.w); *((v2u*)(PB + (size_t)m * 256) + lane) = w; }
    }
    xcd_barrier(xbar);
    { pg8::Gemm g{X2B, Wgate_t, MROWS, 1024, 1024}; pg8::StaticOrder S; S.init(MROWS, 1024, G, bid); pg8::EpiBf16S E{GOUT, 1024, 0, 1.f};
      pg8::gemm_phase<pg8::EpiBf16S, pg8::StaticOrder, true, true>(ldsl, g, S, E); }
    __syncthreads();
    { pg8::Gemm g{PB, Wproj_t, MROWS, 1024, 256}; pg8::StaticOrder S; S.init(MROWS, 1024, G, bid); pg8::EpiBf16S E{EOUT, 1024, 0, 1.f};
      pg8::gemm_phase<pg8::EpiBf16S, pg8::StaticOrder, true, true>(ldsl, g, S, E); }
    xcd_barrier(xbar);
    {
      int tidf_ = threadIdx.x; asm volatile("" : "+v"(tidf_)); const int tid = tidf_, lane = tid & 63, wave = __builtin_amdgcn_readfirstlane(tid >> 6), gw = bid * NWAVES + wave; (void)tid; (void)wave;
      f32x4 ge[4], bg[4];
#pragma unroll
      for (int j = 0; j < 4; ++j) { ge[j] = *(const f32x4*)(args.in[27] + 4 * lane + 256 * j); bg[j] = *(const f32x4*)(args.in[25] + 4 * lane + 256 * j); }
      for (int m = gw; m < MROWS; m += NGW) { f32x4* xr = (f32x4*)(OUT + (size_t)m * DM) + lane; const v2u* x2r = (const v2u*)(X2B + (size_t)m * DM) + lane; const v2u* er = (const v2u*)(EOUT + (size_t)m * DM) + lane; const v2u* gr = (const v2u*)(GOUT + (size_t)m * DM) + lane;
        f32x4 v[4], ex[4], gx[4]; float s = 0.f;
#pragma unroll
        for (int j = 0; j < 4; ++j) { { const v2u wx = __builtin_nontemporal_load(x2r + 64 * j); v[j] = (f32x4){bflo(wx.x), bfhi(wx.x), bflo(wx.y), bfhi(wx.y)}; } const v2u w = __builtin_nontemporal_load(er + 64 * j); ex[j] = (f32x4){bflo(w.x), bfhi(w.x), bflo(w.y), bfhi(w.y)}; const v2u w2 = __builtin_nontemporal_load(gr + 64 * j); gx[j] = (f32x4){bflo(w2.x), bfhi(w2.x), bflo(w2.y), bfhi(w2.y)};
          s += (ex[j].x * ex[j].x + ex[j].y * ex[j].y) + (ex[j].z * ex[j].z + ex[j].w * ex[j].w); }
        const float rs = 1.0f / sqrtf(wave_sum(s) * (1.0f / DM) + EPS);
#pragma unroll
        for (int j = 0; j < 4; ++j) { f32x4 sg;
#pragma unroll
          for (int q = 0; q < 4; ++q) sg[q] = __builtin_amdgcn_rcpf(1.0f + __expf(-(gx[j][q] + bg[j][q])));
          __builtin_nontemporal_store(v[j] + sg * (ex[j] * rs * ge[j]), xr + 64 * j); } } }
}

extern "C" void kernel_launch(void* const* d_in, const int* in_sizes, int n_in, void* d_out, int out_size, void* d_ws, size_t ws_size, hipStream_t stream) {
    static int grid = 0;
    if (grid == 0) {
        if (n_in != 28 || out_size != MROWS * DM || ws_size < WS_END) { fprintf(stderr, "kernel_launch: unexpected shapes: n_in %d out %d ws %zu (need %zu)\n", n_in, out_size, ws_size, (size_t)WS_END); grid = -1; return; }
        int dev = 0, cus = 0, per_cu = 0;
        hipGetDevice(&dev); hipDeviceGetAttribute(&cus, hipDeviceAttributeMultiprocessorCount, dev);
        if (hipFuncSetAttribute((const void*)hymba_fwd, hipFuncAttributeMaxDynamicSharedMemorySize, LDS_BYTES) != hipSuccess) { fprintf(stderr, "kernel_launch: hipFuncSetAttribute failed\n"); grid = -1; return; }
        if (hipOccupancyMaxActiveBlocksPerMultiprocessor(&per_cu, (const void*)hymba_fwd, NWAVES * 64, LDS_BYTES) != hipSuccess || per_cu < 1) { fprintf(stderr, "kernel_launch: occupancy query failed (%d)\n", per_cu); per_cu = 1; }
        (void)hipGetLastError();
        grid = cus * per_cu;
    }
    if (grid < 0) return;
    (void)hipMemsetAsync((char*)d_ws + WS_CTL, 0, CTL_ZERO_BYTES, stream);
    Args a{};
    for (int i = 0; i < 28; ++i) a.in[i] = (const float*)d_in[i];
    a.out = (float*)d_out; a.ws = (unsigned char*)d_ws;
    void* kargs[] = {&a};
    hipError_t e = hipLaunchCooperativeKernel((const void*)hymba_fwd, dim3(grid), dim3(NWAVES * 64), kargs, LDS_BYTES, stream);
    if (e != hipSuccess) fprintf(stderr, "cooperative launch failed: %s (grid %d)\n", hipGetErrorString(e), grid);
}
```
